# Optimizing an MI355X kernel written in HIP

```python
import math
import jax, jax.numpy as jnp
from jax import lax
import numpy as np

D_MODEL = 1024
BATCH = 8
SEQ = 8192
DEPTH = 4
DEC_BATCH = 2
DEC_SEQ = 8192
PAST_LEN = 128

GRID_W = 64
NA_HEADS = 8
NA_HEAD_DIM = 64
NA_W = NA_HEADS * NA_HEAD_DIM
NA_KH_MAX = 8
NA_KW = 16
NA_COL_BLOCK = NA_KW
NA_N_CB = GRID_W // NA_COL_BLOCK
NA_BAND = 2 * NA_KW
LRU_W = 512
LRU_BLOCKS = 8
LRU_BW = LRU_W // LRU_BLOCKS
CONV_W = 4
LRU_C = 8.0
CA_HEADS = 4
CA_HEAD_DIM = 128
CA_W = CA_HEADS * CA_HEAD_DIM
N_MEM = 256
D_FF = 2816
N_BRANCH = 3
IN_COLS = 3 * NA_W + 2 * LRU_W + CA_W
EPS = 1e-6
NEG = -1e30

kernel_name = "hybrid_na_rglru_memory_encoder"


def rmsnorm(x, g):
    xf = x.astype(jnp.float32)
    y = xf * lax.rsqrt(jnp.mean(xf * xf, axis=-1, keepdims=True) + EPS)
    return (y * g.astype(jnp.float32)).astype(x.dtype)


def swiglu(h, w_up, w_down):
    a, b = jnp.split(h @ w_up, 2, axis=-1)
    return (jax.nn.silu(a) * b) @ w_down


def _na_col_tables():
    j = np.arange(NA_N_CB)[:, None, None]
    qc = j * NA_COL_BLOCK + np.arange(NA_COL_BLOCK)[None, :, None]
    bs = np.clip(j * NA_COL_BLOCK - NA_KW // 2, 0, GRID_W - NA_BAND)
    kc = bs + np.arange(NA_BAND)[None, None, :]
    ws = np.clip(qc - NA_KW // 2, 0, GRID_W - NA_KW)
    valid = (kc >= ws) & (kc < ws + NA_KW)
    dc = np.clip(kc - qc, -(NA_KW - 1), NA_KW - 1) + (NA_KW - 1)
    band_idx = bs[:, 0, 0][:, None] + np.arange(NA_BAND)[None, :]
    return band_idx, valid, dc


def neighbourhood_attention(q, k, v, rpb):
    B, T, _ = q.shape
    rows = T // GRID_W
    kh = min(NA_KH_MAX, rows)
    scale = NA_HEAD_DIM ** -0.5

    def grid(a):
        return a.reshape(B, rows, GRID_W, NA_HEADS, NA_HEAD_DIM).transpose(0, 3, 1, 2, 4)

    qg, kg, vg = grid(q), grid(k), grid(v)
    band_idx, valid, dc = _na_col_tables()
    mask = jnp.asarray(valid)[:, :, None, :]
    dc_b = jnp.asarray(dc, dtype=jnp.int32)[:, :, None, :]

    def row_step(r):
        rs = jnp.clip(r - kh // 2, 0, rows - kh)
        k_rows = lax.dynamic_slice_in_dim(kg, rs, kh, axis=2)
        v_rows = lax.dynamic_slice_in_dim(vg, rs, kh, axis=2)
        k_band = k_rows[:, :, :, band_idx, :]
        v_band = v_rows[:, :, :, band_idx, :]
        q_row = lax.dynamic_index_in_dim(qg, r, axis=2, keepdims=False)
        q_row = q_row.reshape(B, NA_HEADS, NA_N_CB, NA_COL_BLOCK, NA_HEAD_DIM)
        s = jnp.einsum('bhjqd,bhkjcd->bhjqkc', q_row, k_band).astype(jnp.float32) * scale
        dr = rs + jnp.arange(kh, dtype=jnp.int32) - r + (NA_KH_MAX - 1)
        bias = rpb[:, dr[None, None, :, None], dc_b]
        s = jnp.where(mask, s + bias.astype(jnp.float32), NEG)
        p = jax.nn.softmax(s.reshape(s.shape[:4] + (kh * NA_BAND,)), axis=-1).reshape(s.shape)
        o = jnp.einsum('bhjqkc,bhkjcd->bhjqd', p.astype(v.dtype), v_band)
        return o.reshape(B, NA_HEADS, GRID_W, NA_HEAD_DIM)

    out = lax.map(row_step, jnp.arange(rows, dtype=jnp.int32))
    return out.transpose(1, 0, 3, 2, 4).reshape(B, T, NA_W)


def centred_conv(x, w, b):
    T = x.shape[1]
    left = CONV_W // 2
    xp = jnp.pad(x, ((0, 0), (left, CONV_W - 1 - left), (0, 0)))
    y = sum(xp[:, i:i + T, :] * w[i] for i in range(CONV_W))
    return y + b


def rg_lru(x, wa, ba, wi, bi, lam, reverse):
    B, T, _ = x.shape
    xb = x.reshape(B, T, LRU_BLOCKS, LRU_BW)
    f32 = jnp.float32
    r = jax.nn.sigmoid(jnp.einsum('btnc,ncd->btnd', xb, wa.astype(f32)).reshape(B, T, LRU_W) + ba.astype(f32))
    i = jax.nn.sigmoid(jnp.einsum('btnc,ncd->btnd', xb, wi.astype(f32)).reshape(B, T, LRU_W) + bi.astype(f32))
    log_a = -LRU_C * r * jax.nn.softplus(-lam.astype(f32))
    a = jnp.exp(log_a)
    u = jnp.sqrt(-jnp.expm1(2.0 * log_a)) * (i * x)

    def combine(e1, e2):
        a1, b1 = e1
        a2, b2 = e2
        return a1 * a2, a2 * b1 + b2

    _, h = lax.associative_scan(combine, (a, u), axis=1, reverse=reverse)
    return h


def memory_attention(q, mem_n, w_kv):
    B, T, _ = q.shape
    M = mem_n.shape[1]
    k, v = jnp.split(mem_n @ w_kv, 2, axis=-1)
    qh = q.reshape(B, T, CA_HEADS, CA_HEAD_DIM)
    kh = k.reshape(B, M, CA_HEADS, CA_HEAD_DIM)
    vh = v.reshape(B, M, CA_HEADS, CA_HEAD_DIM)
    s = jnp.einsum('bthd,bmhd->bhtm', qh, kh).astype(jnp.float32) * (CA_HEAD_DIM ** -0.5)
    p = jax.nn.softmax(s, axis=-1).astype(q.dtype)
    return jnp.einsum('bhtm,bmhd->bthd', p, vh).reshape(B, T, CA_W)


def _layer(x, mem, p, l):
    h = rmsnorm(x, p['g_ffn1_pre'][l])
    x = x + 0.5 * rmsnorm(swiglu(h, p['w_ffn1_up'][l], p['w_ffn1_down'][l]), p['g_ffn1_post'][l])

    h = rmsnorm(x, p['g_mix_pre'][l])
    proj = h @ p['w_in'][l]
    splits = [NA_W, 2 * NA_W, 3 * NA_W, 3 * NA_W + LRU_W, 3 * NA_W + 2 * LRU_W]
    q_na, k_na, v_na, x_lru, g_lru, q_ca = jnp.split(proj, splits, axis=-1)

    y_na = neighbourhood_attention(q_na, k_na, v_na, p['na_rpb'][l])

    xc = centred_conv(x_lru, p['conv_w'][l], p['conv_b'][l]).astype(jnp.float32)
    h_f = rg_lru(xc, p['lru_wa'][l, 0], p['lru_ba'][l, 0], p['lru_wi'][l, 0], p['lru_bi'][l, 0],
                 p['lru_lambda'][l, 0], reverse=False)
    h_b = rg_lru(xc, p['lru_wa'][l, 1], p['lru_ba'][l, 1], p['lru_wi'][l, 1], p['lru_bi'][l, 1],
                 p['lru_lambda'][l, 1], reverse=True)
    y_lru = ((h_f + h_b) * jax.nn.gelu(g_lru.astype(jnp.float32))).astype(x.dtype)

    y_ca = memory_attention(q_ca, rmsnorm(mem, p['g_mem'][l]), p['w_mem_kv'][l])

    gates = jax.nn.sigmoid((h @ p['w_gate'][l] + p['b_gate'][l]).astype(jnp.float32)).astype(x.dtype)
    g_na, g_lr, g_ca = jnp.split(gates, N_BRANCH, axis=-1)
    merged = (g_na * (y_na @ p['w_branch_na'][l])
              + g_lr * (y_lru @ p['w_branch_lru'][l])
              + g_ca * (y_ca @ p['w_branch_ca'][l]))
    x = x + rmsnorm(merged @ p['w_out'][l], p['g_mix_post'][l])

    h = rmsnorm(x, p['g_ffn2_pre'][l])
    x = x + 0.5 * rmsnorm(swiglu(h, p['w_ffn2_up'][l], p['w_ffn2_down'][l]), p['g_ffn2_post'][l])
    return x


def _trunk(x, mem, p):
    for l in range(DEPTH):
        x = _layer(x, mem, p, l)
    return x


def setup_inputs(seed: int = 0) -> dict:
    key = jax.random.key(seed)
    ks = jax.random.split(key, 40)
    f32 = jnp.float32

    def nrm(k, shape, fan_in):
        return jax.random.normal(k, shape, f32) * (fan_in ** -0.5)

    def gain(k, shape):
        return 1.0 + 0.05 * jax.random.normal(k, shape, f32)

    a0 = jax.random.uniform(ks[20], (DEPTH, 2, LRU_W), f32, 0.9, 0.999)
    sig = a0 ** (1.0 / LRU_C)
    lam = jnp.log(sig) - jnp.log1p(-sig)

    return {
        'x_prompt': jax.random.normal(ks[0], (BATCH, SEQ, D_MODEL), f32),
        'x_sample': jax.random.normal(ks[1], (DEC_BATCH, DEC_SEQ, D_MODEL), f32),
        'mem_prompt': jax.random.normal(ks[2], (BATCH, N_MEM, D_MODEL), f32),
        'mem_sample': jax.random.normal(ks[3], (DEC_BATCH, N_MEM, D_MODEL), f32),
        'g_ffn1_pre': gain(ks[4], (DEPTH, D_MODEL)),
        'w_ffn1_up': nrm(ks[5], (DEPTH, D_MODEL, 2 * D_FF), D_MODEL),
        'w_ffn1_down': nrm(ks[6], (DEPTH, D_FF, D_MODEL), D_FF),
        'g_ffn1_post': gain(ks[7], (DEPTH, D_MODEL)),
        'g_mix_pre': gain(ks[8], (DEPTH, D_MODEL)),
        'w_in': nrm(ks[9], (DEPTH, D_MODEL, IN_COLS), D_MODEL),
        'na_rpb': 0.1 * jax.random.normal(ks[10], (DEPTH, NA_HEADS, 2 * NA_KH_MAX - 1, 2 * NA_KW - 1), f32),
        'conv_w': nrm(ks[11], (DEPTH, CONV_W, LRU_W), CONV_W),
        'conv_b': 0.01 * jax.random.normal(ks[12], (DEPTH, LRU_W), f32),
        'lru_wa': nrm(ks[13], (DEPTH, 2, LRU_BLOCKS, LRU_BW, LRU_BW), LRU_BW),
        'lru_ba': 0.1 * jax.random.normal(ks[14], (DEPTH, 2, LRU_W), f32),
        'lru_wi': nrm(ks[15], (DEPTH, 2, LRU_BLOCKS, LRU_BW, LRU_BW), LRU_BW),
        'lru_bi': 0.1 * jax.random.normal(ks[16], (DEPTH, 2, LRU_W), f32),
        'lru_lambda': lam,
        'g_mem': gain(ks[17], (DEPTH, D_MODEL)),
        'w_mem_kv': nrm(ks[18], (DEPTH, D_MODEL, 2 * CA_W), D_MODEL),
        'w_gate': nrm(ks[19], (DEPTH, D_MODEL, N_BRANCH * D_MODEL), D_MODEL),
        'b_gate': 0.1 * jax.random.normal(ks[21], (DEPTH, N_BRANCH * D_MODEL), f32),
        'w_branch_na': nrm(ks[22], (DEPTH, NA_W, D_MODEL), NA_W),
        'w_branch_lru': nrm(ks[23], (DEPTH, LRU_W, D_MODEL), LRU_W),
        'w_branch_ca': nrm(ks[24], (DEPTH, CA_W, D_MODEL), CA_W),
        'w_out': nrm(ks[25], (DEPTH, D_MODEL, D_MODEL), D_MODEL),
        'g_mix_post': gain(ks[26], (DEPTH, D_MODEL)),
        'g_ffn2_pre': gain(ks[27], (DEPTH, D_MODEL)),
        'w_ffn2_up': nrm(ks[28], (DEPTH, D_MODEL, 2 * D_FF), D_MODEL),
        'w_ffn2_down': nrm(ks[29], (DEPTH, D_FF, D_MODEL), D_FF),
        'g_ffn2_post': gain(ks[30], (DEPTH, D_MODEL)),
    }


def reference(x_prompt, x_sample, mem_prompt, mem_sample,
              g_ffn1_pre, w_ffn1_up, w_ffn1_down, g_ffn1_post,
              g_mix_pre, w_in, na_rpb, conv_w, conv_b,
              lru_wa, lru_ba, lru_wi, lru_bi, lru_lambda,
              g_mem, w_mem_kv, w_gate, b_gate,
              w_branch_na, w_branch_lru, w_branch_ca, w_out, g_mix_post,
              g_ffn2_pre, w_ffn2_up, w_ffn2_down, g_ffn2_post):
    p = dict(
        g_ffn1_pre=g_ffn1_pre, w_ffn1_up=w_ffn1_up, w_ffn1_down=w_ffn1_down, g_ffn1_post=g_ffn1_post,
        g_mix_pre=g_mix_pre, w_in=w_in, na_rpb=na_rpb, conv_w=conv_w, conv_b=conv_b,
        lru_wa=lru_wa, lru_ba=lru_ba, lru_wi=lru_wi, lru_bi=lru_bi, lru_lambda=lru_lambda,
        g_mem=g_mem, w_mem_kv=w_mem_kv, w_gate=w_gate, b_gate=b_gate,
        w_branch_na=w_branch_na, w_branch_lru=w_branch_lru, w_branch_ca=w_branch_ca,
        w_out=w_out, g_mix_post=g_mix_post,
        g_ffn2_pre=g_ffn2_pre, w_ffn2_up=w_ffn2_up, w_ffn2_down=w_ffn2_down, g_ffn2_post=g_ffn2_post,
    )
    y_prompt = _trunk(x_prompt, mem_prompt, p)
    y_sample = _trunk(x_sample, mem_sample, p)
    return (y_prompt, y_sample)
```

```cpp
#include <hip/hip_runtime.h>
#include <hip/hip_cooperative_groups.h>
#include <cstdio>
#include <cstdint>
namespace cg = cooperative_groups;

#ifndef MULTI_LAUNCH
#define MULTI_LAUNCH 0
#endif

#define LAS __attribute__((address_space(3)))
typedef unsigned short bf16_t;
typedef short bf16x8 __attribute__((ext_vector_type(8)));
typedef float f32x4 __attribute__((ext_vector_type(4)));
typedef unsigned u32x4 __attribute__((ext_vector_type(4)));
typedef unsigned u32x2 __attribute__((ext_vector_type(2)));

constexpr int T = 81920, SEQ = 8192, NBAT = 10, NL = 4, DFF = 2816;
constexpr int PC = 3072;
constexpr float EPS = 1e-6f;

constexpr size_t WL = 27394048;
constexpr size_t OFF_UP1 = 0, OFF_DN1 = 5767168, OFF_UP2 = 8650752, OFF_DN2 = 14417920, OFF_IN = 17301504,
                 OFF_GATE = 20447232, OFF_BR = 23592960, OFF_OUT = 25165824, OFF_KV = 26214400, OFF_LRU = 27262976;
constexpr size_t WS_CTL = 0;
constexpr size_t WS_AGG = 65536;
constexpr size_t WS_W = 3u << 20;
constexpr size_t WS_KVB = WS_W + 4 * WL * 2;
constexpr size_t WS_A = WS_KVB + (size_t)4 * 2560 * 1024 * 2;
constexpr size_t WS_B = WS_A + (size_t)T * 1024 * 2;
constexpr size_t WS_S = WS_B + (size_t)T * 3072 * 2;
constexpr size_t WS_VTC = WS_S + (size_t)T * 512 * 2;
constexpr size_t WS_END = WS_VTC + (size_t)4 * 10 * 4 * 128 * 256 * 2;
static_assert(WS_END <= (size_t)1 << 30, "workspace");
constexpr int LDS_BYTES = 147456;

typedef float f32x2_t __attribute__((ext_vector_type(2)));
typedef __bf16 bf16x2_t __attribute__((ext_vector_type(2)));
__device__ __forceinline__ unsigned cvt_pk_bf16(float lo, float hi) { const f32x2_t v = {lo, hi}; const bf16x2_t b = __builtin_convertvector(v, bf16x2_t); return __builtin_bit_cast(unsigned, b); }
__device__ __forceinline__ float bflo(unsigned w) { return __uint_as_float(w << 16); }
__device__ __forceinline__ float bfhi(unsigned w) { return __uint_as_float(w & 0xffff0000u); }
__device__ __forceinline__ float bf2f(bf16_t v) { return __uint_as_float((unsigned)v << 16); }
__device__ __forceinline__ float sigmoidf_(float x) { return __builtin_amdgcn_rcpf(1.0f + __expf(-x)); }
__device__ __forceinline__ float wave_sum(float v) {
#pragma unroll
    for (int o = 1; o < 64; o <<= 1) v += __shfl_xor(v, o);
    return v;
}
__device__ __forceinline__ float gelu_tanh(float x) {
    const float t = __builtin_fmaf(x * x, 2.302208198f * 0.044715f, 2.302208198f);
    const float r = __builtin_amdgcn_rcpf(__builtin_amdgcn_exp2f(x * t) + 1.0f);
    return __builtin_fmaf(-x, r, x);
}

namespace pg8 {
constexpr int BM = 256, BK = 64, HALF = 128, HTB = HALF * BK * 2, STAGE_BYTES = 8 * HTB, NXCD = 8, WGM = 8;
__host__ __device__ __forceinline__ int lds_byte(int r, int c) { const int st = (r >> 4) * 2 + (c >> 5), rr = r & 15, cc = c & 31, ob = rr * 64 + cc * 2; return st * 1024 + (ob ^ (((ob >> 9) & 1) << 5)); }
__host__ __device__ __forceinline__ void stage_rc(int b, int& R, int& C) { const int st = b / 1024, sb = b % 1024, swz = sb ^ (((sb >> 9) & 1) << 5); R = (st >> 1) * 16 + swz / 64; C = (st & 1) * 32 + (swz % 64) / 2; }
__host__ __device__ __forceinline__ int perm32(int rho) { const int n = rho >> 4, i = rho & 15; return 8 * (i >> 2) + 4 * n + (i & 3); }

struct Unit { const char* A; const char* B; int lda, ldb, nt, pm, pn, sub; };

struct StaticOrder {
    int nM, nN, nwg, G, c;
    __device__ void init(int M, int N, int G_, int c_) { nM = M / BM; nN = N / BM; nwg = nM * nN; G = G_; c = c_; }
    __device__ bool next(int i, int& pm, int& pn) const {
        const long L = (long)i * G + c; if (__builtin_amdgcn_readfirstlane((int)(L >= nwg))) return false;
        int wgid = (int)L; { const int q = nwg / NXCD, r = nwg % NXCD, xcd = wgid % NXCD, off = wgid / NXCD; wgid = (xcd < r ? xcd * (q + 1) : r * (q + 1) + (xcd - r) * q) + off; }
        const int nig = WGM * nN, gid = wgid / nig, t = wgid - gid * nig, fm = gid * WGM, gsz = (nM - fm) < WGM ? (nM - fm) : WGM;
        int pm_, pn_;
        if (gsz == WGM) { pm_ = fm + (t & (WGM - 1)); pn_ = t >> 3; }
        else { pm_ = fm + t % gsz; pn_ = t / gsz; }
        pm = __builtin_amdgcn_readfirstlane(pm_); pn = __builtin_amdgcn_readfirstlane(pn_); return true;
    }
};

template <class Epi, class Sched>
__device__ __forceinline__ void gemm_phase(LAS unsigned char* lds, const int tid, const Sched& S, const Epi& E) {
    const int wid = __builtin_amdgcn_readfirstlane(tid >> 6), lane = tid & 63, wr = wid >> 2, wc = wid & 3, fr = lane & 15, fq = lane >> 4;
    int R0, C0; stage_rc(tid * 16, R0, C0);
    const int RB = Epi::PERM ? ((R0 & ~31) + perm32(R0 & 31)) : R0;
    const unsigned CB = (unsigned)C0 * 2u;
    const unsigned ldsw = (unsigned)wid * 1024u;
    const int aoff = lds_byte(wr * 64 + fr, fq * 8), boff = lds_byte(wc * 32 + fr, fq * 8);
#define PG8_SA(b, h) (((b) * 2 + (h)) * HTB)
#define PG8_SB(b, h) ((4 + (b) * 2 + (h)) * HTB)
#define PG8_STAGE(bufoff, gbase, off, q) do { \
        __builtin_amdgcn_global_load_lds((const unsigned*)((const char*)(gbase) + (off)), (LAS unsigned*)(lds + (bufoff) + ldsw), 16, 0, 0); \
        __builtin_amdgcn_global_load_lds((const unsigned*)((const char*)(gbase) + (q) + (off)), (LAS unsigned*)(lds + (bufoff) + ldsw + 8192), 16, 0, 0); } while (0)
#define PG8_LDA(dst, b, h) do { _Pragma("unroll") for (int m = 0; m < 4; ++m) _Pragma("unroll") for (int k = 0; k < 2; ++k) dst[m][k] = *(const LAS bf16x8*)(lds + PG8_SA(b, h) + aoff + m * 2048 + k * 1024); } while (0)
#define PG8_LDB(dst, b, h) do { _Pragma("unroll") for (int n = 0; n < 2; ++n) _Pragma("unroll") for (int k = 0; k < 2; ++k) dst[n][k] = *(const LAS bf16x8*)(lds + PG8_SB(b, h) + boff + n * 2048 + k * 1024); } while (0)
#define PG8_MMA(ai, bj, At, Bt) do { __builtin_amdgcn_s_setprio(1); _Pragma("unroll") for (int m = 0; m < 4; ++m) _Pragma("unroll") for (int n = 0; n < 2; ++n) _Pragma("unroll") for (int k = 0; k < 2; ++k) \
        acc[ai][bj][m][n] = __builtin_amdgcn_mfma_f32_16x16x32_bf16(Bt[n][k], At[m][k], acc[ai][bj][m][n], 0, 0, 0); __builtin_amdgcn_s_setprio(0); } while (0)
#define PG8_WAIT_V(n) asm volatile("s_waitcnt vmcnt(" #n ")" ::: "memory")
#define PG8_WAIT_L(n) asm volatile("s_waitcnt lgkmcnt(" #n ")" ::: "memory")
#define PG8_BAR __builtin_amdgcn_s_barrier()
#define PG8_SCHED __builtin_amdgcn_sched_barrier(0)
    Unit cur, nxt; int ui = 0;
    if (!S.next(0, cur)) return;
    f32x4 acc[2][2][4][2];
#pragma unroll
    for (int a = 0; a < 2; ++a)
#pragma unroll
        for (int b = 0; b < 2; ++b)
#pragma unroll
            for (int m = 0; m < 4; ++m)
#pragma unroll
                for (int n = 0; n < 2; ++n) acc[a][b][m][n] = (f32x4){0.f, 0.f, 0.f, 0.f};
    bf16x8 At[4][2], B0[2][2], B1[2][2];
    const char* cA = cur.A; const char* cB = cur.B;
    unsigned offA = (unsigned)R0 * (unsigned)cur.lda + CB, offB = (unsigned)RB * (unsigned)cur.ldb + CB;
    int qA = 64 * cur.lda, qB = 64 * cur.ldb;
    int hA = 128 * cur.lda, hB = 128 * cur.ldb;
    constexpr int kstep = BK * 2;
    PG8_STAGE(PG8_SB(0, 0), cB, offB, qB); PG8_STAGE(PG8_SB(0, 1), cB + hB, offB, qB); PG8_STAGE(PG8_SA(0, 0), cA, offA, qA); PG8_STAGE(PG8_SA(0, 1), cA + hA, offA, qA);
    if (wr == 1) PG8_BAR;
    PG8_WAIT_V(2); PG8_BAR;
    PG8_STAGE(PG8_SB(1, 0), cB + kstep, offB, qB); PG8_STAGE(PG8_SA(1, 0), cA + kstep, offA, qA); PG8_STAGE(PG8_SB(1, 1), cB + hB + kstep, offB, qB);
    PG8_WAIT_V(6); PG8_BAR;
    for (;;) {
        const bool has_next = S.next(ui + 1, nxt);
        const char* nA = has_next ? nxt.A : cA; const char* nB = has_next ? nxt.B : cB;
        const int nlda = has_next ? nxt.lda : cur.lda, nldb = has_next ? nxt.ldb : cur.ldb;
        unsigned noffA, noffB;
        { int t3 = tid; asm volatile("" : "+v"(t3));
          int R0n, C0n; stage_rc(t3 * 16, R0n, C0n); const int RBn = Epi::PERM ? ((R0n & ~31) + perm32(R0n & 31)) : R0n;
          noffA = (unsigned)R0n * (unsigned)nlda + (unsigned)C0n * 2u; noffB = (unsigned)RBn * (unsigned)nldb + (unsigned)C0n * 2u; }
        const int nqA = 64 * nlda, nqB = 64 * nldb, nhA = 128 * nlda, nhB = 128 * nldb;
        const int nt = cur.nt;
        for (int t = 0; t < nt; t += 2) {
            const bool last = (t == nt - 2);
            const char* a1 = cA + (size_t)(t + 1) * kstep;
            const char* a2 = last ? nA : cA + (size_t)(t + 2) * kstep; const char* b2 = last ? nB : cB + (size_t)(t + 2) * kstep;
            const char* a3 = a2 + kstep; const char* b3 = b2 + kstep;
            const unsigned oA2 = last ? noffA : offA, oB2 = last ? noffB : offB;
            const int qA2 = last ? nqA : qA, qB2 = last ? nqB : qB, hA2 = last ? nhA : hA, hB2 = last ? nhB : hB;
            PG8_LDB(B0, 0, 0); PG8_LDB(B1, 0, 1); PG8_SCHED; PG8_LDA(At, 0, 0); PG8_STAGE(PG8_SA(1, 1), a1 + hA, offA, qA);
            PG8_WAIT_V(8); PG8_WAIT_L(0); PG8_BAR; PG8_MMA(0, 0, At, B0); PG8_MMA(0, 1, At, B1); PG8_BAR; PG8_SCHED;
            PG8_LDA(At, 0, 1); PG8_STAGE(PG8_SB(0, 0), b2, oB2, qB2); PG8_STAGE(PG8_SB(0, 1), b2 + hB2, oB2, qB2); PG8_STAGE(PG8_SA(0, 0), a2, oA2, qA2);
            PG8_WAIT_V(8); PG8_WAIT_L(0); PG8_BAR; PG8_MMA(1, 0, At, B0); PG8_MMA(1, 1, At, B1); PG8_BAR; PG8_SCHED;
            PG8_LDB(B0, 1, 0); PG8_LDB(B1, 1, 1); PG8_SCHED; PG8_LDA(At, 1, 0); PG8_STAGE(PG8_SA(0, 1), a2 + hA2, oA2, qA2);
            PG8_WAIT_V(8); PG8_WAIT_L(0); PG8_BAR; PG8_MMA(0, 0, At, B0); PG8_MMA(0, 1, At, B1); PG8_BAR; PG8_SCHED;
            PG8_LDA(At, 1, 1); PG8_STAGE(PG8_SB(1, 0), b3, oB2, qB2); PG8_STAGE(PG8_SB(1, 1), b3 + hB2, oB2, qB2); PG8_STAGE(PG8_SA(1, 0), a3, oA2, qA2);
            PG8_WAIT_V(8); PG8_WAIT_L(0); PG8_BAR; PG8_MMA(1, 0, At, B0); PG8_MMA(1, 1, At, B1); PG8_BAR; PG8_SCHED;
        }
        if (wr == 0) PG8_BAR;
        { int t4 = tid; asm volatile("" : "+v"(t4));
          E(acc, cur, t4, wr, wc, t4 & 15, (t4 & 63) >> 4); }
        if (!has_next) break;
#pragma unroll
        for (int a = 0; a < 2; ++a)
#pragma unroll
            for (int b = 0; b < 2; ++b)
#pragma unroll
                for (int m = 0; m < 4; ++m)
#pragma unroll
                    for (int n = 0; n < 2; ++n) acc[a][b][m][n] = (f32x4){0.f, 0.f, 0.f, 0.f};
        cur = nxt; cA = nA; cB = nB; offA = noffA; offB = noffB; qA = nqA; qB = nqB; hA = nhA; hB = nhB; ++ui;
        if (wr == 1) PG8_BAR;
    }
    PG8_WAIT_V(0);
    PG8_BAR;
#undef PG8_SA
#undef PG8_SB
#undef PG8_STAGE
#undef PG8_LDA
#undef PG8_LDB
#undef PG8_MMA
#undef PG8_WAIT_V
#undef PG8_WAIT_L
#undef PG8_BAR
#undef PG8_SCHED
}
}

struct USched {
    int kind;
    pg8::StaticOrder o; const char* A; const char* B; int lda, ldb, nt;
    const char* Wg; const char* Wbr;
    const char* PB;
    __device__ __forceinline__ bool next(int i, pg8::Unit& u) const {
        if (kind == 0) {
            int pm, pn; if (!o.next(i, pm, pn)) return false;
            u.A = A + (size_t)pm * 256 * lda; u.B = B + (size_t)pn * 256 * ldb; u.lda = lda; u.ldb = ldb; u.nt = nt; u.pm = pm; u.pn = pn; u.sub = 0; return true;
        } else if (kind == 1) {
            const int L = i * o.G + o.c; if (L >= 160) return false;
            const int l = L / 40, r = L % 40, pm = r >> 2, pn = r & 3;
            u.A = A + ((size_t)l * 2560 + pm * 256) * 2048; u.B = B + ((size_t)l * WL + OFF_KV) * 2 + (size_t)pn * 256 * 2048;
            u.lda = 2048; u.ldb = 2048; u.nt = 16; u.pm = l * 10 + pm; u.pn = pn; u.sub = 0; return true;
        } else {
            const int tile = i / 6, s = i - tile * 6, br = s >> 1;
            int pm, pn; if (!o.next(tile, pm, pn)) return false;
            u.pm = pm; u.pn = pn; u.sub = s;
            if (!(s & 1)) { u.A = A + (size_t)pm * 256 * 2048; u.lda = 2048; u.B = Wg + ((size_t)br * 1024 + pn * 256) * 2048; u.ldb = 2048; u.nt = 16; }
            else { const int co = br == 0 ? 0 : (br == 1 ? 2048 : 2560);
                   u.A = PB + (size_t)pm * 256 * (PC * 2) + co * 2; u.lda = PC * 2; u.B = Wbr + (size_t)br * (1024 * 512 * 2) + (size_t)pn * 256 * 1024; u.ldb = 1024; u.nt = 8; }
            return true;
        }
    }
};
struct UEpi {
    static constexpr bool PERM = true;
    int kind;
    bf16_t* O; int ldc; const float* bgate; u32x4* park;
    int vt; bf16_t* VT;
    __device__ __forceinline__ void operator()(const f32x4 (&acc)[2][2][4][2], const pg8::Unit& u, int tid, int wr, int wc, int fr, int fq) const {
        const int row0 = u.pm * 256 + wr * 64 + fr;
        if (kind == 0 && ((vt == 1 && (u.pn == 4 || u.pn == 5)) || (vt == 2 && u.pn >= 2))) {
#pragma unroll
            for (int ai = 0; ai < 2; ++ai)
#pragma unroll
                for (int m = 0; m < 4; ++m) {
                    const int row = row0 + ai * 128 + m * 16;
                    size_t rbase; int dstride;
                    if (vt == 1) { const int b = row >> 13, t = row & 8191, r = t >> 6, c = t & 63; rbase = ((size_t)(b * 8) * 128 + r) * 4096 + c; dstride = 64; }
                    else { const int l = row / 2560, rem = row - l * 2560, b = rem >> 8, key = rem & 255, kk = key & 31;
                           rbase = ((size_t)(l * 10 + b) * 4) * 32768 + (key >> 5) * 32 + 8 * ((kk & 15) >> 2) + 4 * (kk >> 4) + (kk & 3); dstride = 256; }
#pragma unroll
                    for (int bj = 0; bj < 2; ++bj) {
                        const int col = (vt == 1 ? (u.pn - 4) : (u.pn - 2)) * 256 + bj * 128 + wc * 32 + 8 * fq;
                        const int hh = vt == 1 ? (col >> 6) : (col >> 7), d = vt == 1 ? (col & 63) : (col & 127);
                        bf16_t* p = VT + rbase + (vt == 1 ? (size_t)hh * 128 * 4096 : (size_t)hh * 32768) + (size_t)d * dstride;
                        const f32x4 v0 = acc[ai][bj][m][0], v1 = acc[ai][bj][m][1];
                        const unsigned w0 = cvt_pk_bf16(v0[0], v0[1]), w1 = cvt_pk_bf16(v0[2], v0[3]), w2 = cvt_pk_bf16(v1[0], v1[1]), w3 = cvt_pk_bf16(v1[2], v1[3]);
                        p[0 * dstride] = (bf16_t)(w0 & 0xffffu); p[1 * dstride] = (bf16_t)(w0 >> 16); p[2 * dstride] = (bf16_t)(w1 & 0xffffu); p[3 * dstride] = (bf16_t)(w1 >> 16);
                        p[4 * dstride] = (bf16_t)(w2 & 0xffffu); p[5 * dstride] = (bf16_t)(w2 >> 16); p[6 * dstride] = (bf16_t)(w3 & 0xffffu); p[7 * dstride] = (bf16_t)(w3 >> 16);
                    }
                    if (m & 1) asm volatile("" ::: "memory");
                }
        } else if (kind == 0) {
            const int col0 = u.pn * 256 + wc * 32 + 8 * fq;
            unsigned off = ((unsigned)row0 * (unsigned)ldc + (unsigned)col0) * 2u; const unsigned rstep = 16u * (unsigned)ldc * 2u;
#pragma unroll
            for (int ai = 0; ai < 2; ++ai) {
#pragma unroll
                for (int m = 0; m < 4; ++m) {
#pragma unroll
                    for (int bj = 0; bj < 2; ++bj) { const f32x4 v0 = acc[ai][bj][m][0], v1 = acc[ai][bj][m][1];
                        u32x4 w; w.x = cvt_pk_bf16(v0[0], v0[1]); w.y = cvt_pk_bf16(v0[2], v0[3]); w.z = cvt_pk_bf16(v1[0], v1[1]); w.w = cvt_pk_bf16(v1[2], v1[3]);
                        *(u32x4*)((char*)O + off + bj * 256) = w; }
                    off += rstep; }
                off += 4u * rstep; }
        } else if (kind == 1) {
            const int col0 = u.pn * 128 + wc * 32 + 8 * fq;
#pragma unroll
            for (int ai = 0; ai < 2; ++ai)
#pragma unroll
                for (int m = 0; m < 4; ++m) {
                    float r[8];
#pragma unroll
                    for (int n = 0; n < 2; ++n)
#pragma unroll
                        for (int e = 0; e < 4; ++e) { const float av = acc[ai][0][m][n][e], bv = acc[ai][1][m][n][e]; r[n * 4 + e] = av * sigmoidf_(av) * bv; }
                    u32x4 w; w.x = cvt_pk_bf16(r[0], r[1]); w.y = cvt_pk_bf16(r[2], r[3]); w.z = cvt_pk_bf16(r[4], r[5]); w.w = cvt_pk_bf16(r[6], r[7]);
                    *(u32x4*)((char*)O + ((unsigned)(row0 + ai * 128 + m * 16) * (unsigned)DFF + (unsigned)col0) * 2u) = w; }
        } else {
            const int br = u.sub >> 1; const bool isg = !(u.sub & 1);
            const int col0 = u.pn * 256 + wc * 32 + 8 * fq;
            u32x4* pk = park + tid; asm volatile("" : "+v"(pk));
#pragma unroll
            for (int bj = 0; bj < 2; ++bj) {
                f32x4 b0 = (f32x4){0.f, 0.f, 0.f, 0.f}, b1 = b0;
                if (isg) { const float* bp = bgate + br * 1024 + col0 + bj * 128; b0 = *(const f32x4*)bp * -1.4426950408889634f; b1 = *(const f32x4*)(bp + 4) * -1.4426950408889634f; }
#pragma unroll
                for (int ai = 0; ai < 2; ++ai)
#pragma unroll
                    for (int m = 0; m < 4; ++m) {
                        const f32x4 v0 = acc[ai][bj][m][0], v1 = acc[ai][bj][m][1];
                        u32x4* slot = pk + ((ai * 4 + m) * 2 + bj) * 512;
                        if (isg) {
#define SG2(v, bb) __builtin_amdgcn_rcpf(1.0f + __builtin_amdgcn_exp2f(__builtin_fmaf((v), -1.4426950408889634f, (bb))))
                            u32x4 w; w.x = cvt_pk_bf16(SG2(v0[0], b0[0]), SG2(v0[1], b0[1])); w.y = cvt_pk_bf16(SG2(v0[2], b0[2]), SG2(v0[3], b0[3]));
                            w.z = cvt_pk_bf16(SG2(v1[0], b1[0]), SG2(v1[1], b1[1])); w.w = cvt_pk_bf16(SG2(v1[2], b1[2]), SG2(v1[3], b1[3]));
#undef SG2
                            *slot = w;
                        } else {
                            const u32x4 g = *slot;
                            bf16_t* op = (bf16_t*)((char*)O + ((unsigned)(row0 + ai * 128 + m * 16) * (unsigned)ldc + (unsigned)(col0 + bj * 128)) * 2u);
                            float r[8];
                            r[0] = bflo(g.x) * v0[0]; r[1] = bfhi(g.x) * v0[1]; r[2] = bflo(g.y) * v0[2]; r[3] = bfhi(g.y) * v0[3];
                            r[4] = bflo(g.z) * v1[0]; r[5] = bfhi(g.z) * v1[1]; r[6] = bflo(g.w) * v1[2]; r[7] = bfhi(g.w) * v1[3];
                            if (br > 0) { const u32x4 o = *(const u32x4*)op;
                                r[0] += bflo(o.x); r[1] += bfhi(o.x); r[2] += bflo(o.y); r[3] += bfhi(o.y); r[4] += bflo(o.z); r[5] += bfhi(o.z); r[6] += bflo(o.w); r[7] += bfhi(o.w); }
                            u32x4 w; w.x = cvt_pk_bf16(r[0], r[1]); w.y = cvt_pk_bf16(r[2], r[3]); w.z = cvt_pk_bf16(r[4], r[5]); w.w = cvt_pk_bf16(r[6], r[7]);
                            *(u32x4*)op = w;
                        }
                        if (m & 1) asm volatile("" ::: "memory");
                    }
            }
        }
    }
};

struct Args { const float* in[31]; float* out; unsigned char* ws; int ph_lo, ph_hi; };
struct Ctx {
    LAS unsigned long long* tab; int tid;
    __device__ __forceinline__ unsigned long long rd(int k) const { const unsigned long long v = tab[k];
        const unsigned lo = __builtin_amdgcn_readfirstlane((unsigned)v), hi = __builtin_amdgcn_readfirstlane((unsigned)(v >> 32)); return ((unsigned long long)hi << 32) | lo; }
    __device__ __forceinline__ const float* in(int k) const { return (const float*)(const __attribute__((address_space(1))) float*)rd(k); }
    __device__ __forceinline__ float* out() const { return (float*)(__attribute__((address_space(1))) float*)rd(31); }
    __device__ __forceinline__ unsigned char* ws() const { return (unsigned char*)(__attribute__((address_space(1))) unsigned char*)rd(32); }
};

__device__ __forceinline__ void tr_item(const float* W, int K, int N, bf16_t* WT, int item, LAS float* scr, int lane, bool upmap) {
    const int nblk = N / 32, kb = item / nblk, nb = item % nblk, k0 = 64 * kb, n0 = 32 * nb;
#pragma unroll 8
    for (int i = 0; i < 32; ++i) { const int kk = 2 * i + (lane >> 5); scr[kk * 33 + (lane & 31)] = W[(size_t)(k0 + kk) * N + n0 + (lane & 31)]; }
    asm volatile("s_waitcnt lgkmcnt(0)" ::: "memory");
    int row0 = n0;
    if (upmap) { if (n0 < DFF) row0 = 256 * (n0 / 128) + (n0 % 128); else { const int c2 = n0 - DFF; row0 = 256 * (c2 / 128) + 128 + (c2 % 128); } }
    const int c = lane & 7;
#pragma unroll
    for (int j = 0; j < 4; ++j) { const int n = (lane >> 3) + 8 * j; const LAS float* s = scr + (8 * c) * 33 + n;
        u32x4 o; o.x = cvt_pk_bf16(s[0 * 33], s[1 * 33]); o.y = cvt_pk_bf16(s[2 * 33], s[3 * 33]); o.z = cvt_pk_bf16(s[4 * 33], s[5 * 33]); o.w = cvt_pk_bf16(s[6 * 33], s[7 * 33]);
        *(u32x4*)(WT + (size_t)(row0 + n) * K + k0 + 8 * c) = o; }
    asm volatile("s_waitcnt lgkmcnt(0)" ::: "memory");
}

__device__ __forceinline__ void p0_prologue(const Ctx& a, LAS unsigned char* lds) {
    const int tid = a.tid, lane = tid & 63, wave = tid >> 6;
    const int gw = blockIdx.x * 8 + wave, NGW = gridDim.x * 8;
    LAS float* scr = (LAS float*)(lds + wave * 16384);
    bf16_t* Wb = (bf16_t*)(a.ws() + WS_W);
    constexpr int I_UP = 16 * 176, I_DN = 44 * 32, I_IN = 16 * 96, I_BR = 8 * 32, I_SQ = 16 * 32, I_LRU = 64;
    constexpr int ITEMS_L = 2 * I_UP + 2 * I_DN + 2 * I_IN + 3 * I_BR + 2 * I_SQ + I_LRU;
    for (int it = gw; it < NL * ITEMS_L; it += NGW) {
        const int l = it / ITEMS_L; int r = it - l * ITEMS_L;
        bf16_t* WLb = Wb + (size_t)l * WL;
        if (r < I_UP) { tr_item(a.in(5) + (size_t)l * 1024 * 5632, 1024, 5632, WLb + OFF_UP1, r, scr, lane, true); continue; } r -= I_UP;
        if (r < I_DN) { tr_item(a.in(6) + (size_t)l * DFF * 1024, DFF, 1024, WLb + OFF_DN1, r, scr, lane, false); continue; } r -= I_DN;
        if (r < I_UP) { tr_item(a.in(28) + (size_t)l * 1024 * 5632, 1024, 5632, WLb + OFF_UP2, r, scr, lane, true); continue; } r -= I_UP;
        if (r < I_DN) { tr_item(a.in(29) + (size_t)l * DFF * 1024, DFF, 1024, WLb + OFF_DN2, r, scr, lane, false); continue; } r -= I_DN;
        if (r < I_IN) { tr_item(a.in(9) + (size_t)l * 1024 * 3072, 1024, 3072, WLb + OFF_IN, r, scr, lane, false); continue; } r -= I_IN;
        if (r < I_IN) { tr_item(a.in(20) + (size_t)l * 1024 * 3072, 1024, 3072, WLb + OFF_GATE, r, scr, lane, false); continue; } r -= I_IN;
        if (r < I_BR) { tr_item(a.in(22) + (size_t)l * 512 * 1024, 512, 1024, WLb + OFF_BR, r, scr, lane, false); continue; } r -= I_BR;
        if (r < I_BR) { tr_item(a.in(23) + (size_t)l * 512 * 1024, 512, 1024, WLb + OFF_BR + 1024 * 512, r, scr, lane, false); continue; } r -= I_BR;
        if (r < I_BR) { tr_item(a.in(24) + (size_t)l * 512 * 1024, 512, 1024, WLb + OFF_BR + 2 * 1024 * 512, r, scr, lane, false); continue; } r -= I_BR;
        if (r < I_SQ) { tr_item(a.in(25) + (size_t)l * 1024 * 1024, 1024, 1024, WLb + OFF_OUT, r, scr, lane, false); continue; } r -= I_SQ;
        if (r < I_SQ) { tr_item(a.in(19) + (size_t)l * 1024 * 1024, 1024, 1024, WLb + OFF_KV, r, scr, lane, false); continue; } r -= I_SQ;
        { const int half = r & 1, n = (r >> 1) & 7, mat = (r >> 4) & 1, dir = r >> 5;
          const float* src = (mat ? a.in(15) : a.in(13)) + ((size_t)(l * 2 + dir) * 8 + n) * 4096;
          tr_item(src, 64, 64, WLb + OFF_LRU + ((size_t)(dir * 2 + mat) * 8 + n) * 4096, half, scr, lane, false); }
    }
    bf16_t* memN = (bf16_t*)(a.ws() + WS_B);
    for (int row = gw; row < 2560; row += NGW) {
        const float* src = row < 2048 ? a.in(2) + (size_t)row * 1024 : a.in(3) + (size_t)(row - 2048) * 1024;
        f32x4 v[4]; float ss = 0.f;
#pragma unroll
        for (int j = 0; j < 4; ++j) { v[j] = *(const f32x4*)(src + 4 * lane + 256 * j); ss += v[j][0] * v[j][0] + v[j][1] * v[j][1] + v[j][2] * v[j][2] + v[j][3] * v[j][3]; }
        const float rs = rsqrtf(wave_sum(ss) * (1.f / 1024.f) + EPS);
        for (int l = 0; l < NL; ++l) {
#pragma unroll
            for (int j = 0; j < 4; ++j) { const f32x4 g = *(const f32x4*)(a.in(18) + l * 1024 + 4 * lane + 256 * j);
                u32x2 w; w.x = cvt_pk_bf16(v[j][0] * rs * g[0], v[j][1] * rs * g[1]); w.y = cvt_pk_bf16(v[j][2] * rs * g[2], v[j][3] * rs * g[3]);
                *(u32x2*)(memN + ((size_t)l * 2560 + row) * 1024 + 4 * lane + 256 * j) = w; }
        }
    }
    bf16_t* HA = (bf16_t*)(a.ws() + WS_A);
    for (int row = gw; row < T; row += NGW) {
        const float* src = row < 65536 ? a.in(0) + (size_t)row * 1024 : a.in(1) + (size_t)(row - 65536) * 1024;
        f32x4 v[4]; float ss = 0.f;
#pragma unroll
        for (int j = 0; j < 4; ++j) { v[j] = *(const f32x4*)(src + 4 * lane + 256 * j); ss += v[j][0] * v[j][0] + v[j][1] * v[j][1] + v[j][2] * v[j][2] + v[j][3] * v[j][3]; }
        const float rs = rsqrtf(wave_sum(ss) * (1.f / 1024.f) + EPS);
#pragma unroll
        for (int j = 0; j < 4; ++j) { const f32x4 g = *(const f32x4*)(a.in(4) + 4 * lane + 256 * j);
            *(f32x4*)(a.out() + (size_t)row * 1024 + 4 * lane + 256 * j) = v[j];
            u32x2 w; w.x = cvt_pk_bf16(v[j][0] * rs * g[0], v[j][1] * rs * g[1]); w.y = cvt_pk_bf16(v[j][2] * rs * g[2], v[j][3] * rs * g[3]);
            *(u32x2*)(HA + (size_t)row * 1024 + 4 * lane + 256 * j) = w; }
    }
}

__device__ __forceinline__ void e_phase(const Ctx& a, float* X, bf16_t* FA, const float* gpost, float scale, const float* gpre) {
    const int tid = a.tid, lane = tid & 63, wave = tid >> 6;
    const int gw = blockIdx.x * 8 + wave, NGW = gridDim.x * 8;
    u32x2 fn[4]; f32x4 xn[4];
    if (gw < T) {
#pragma unroll
        for (int j = 0; j < 4; ++j) { fn[j] = *(const u32x2*)(FA + (size_t)gw * 1024 + 4 * lane + 256 * j); xn[j] = __builtin_nontemporal_load((const f32x4*)(X + (size_t)gw * 1024 + 4 * lane + 256 * j)); }
    }
    for (int row = gw; row < T; row += NGW) {
        float* xr = X + (size_t)row * 1024; bf16_t* fr = FA + (size_t)row * 1024;
        f32x4 f[4], x[4]; float ss = 0.f;
#pragma unroll
        for (int j = 0; j < 4; ++j) { f[j] = (f32x4){bflo(fn[j].x), bfhi(fn[j].x), bflo(fn[j].y), bfhi(fn[j].y)}; x[j] = xn[j];
            ss += f[j][0] * f[j][0] + f[j][1] * f[j][1] + f[j][2] * f[j][2] + f[j][3] * f[j][3]; }
        const int nrow = row + NGW;
        if (nrow < T) {
#pragma unroll
            for (int j = 0; j < 4; ++j) { fn[j] = *(const u32x2*)(FA + (size_t)nrow * 1024 + 4 * lane + 256 * j); xn[j] = __builtin_nontemporal_load((const f32x4*)(X + (size_t)nrow * 1024 + 4 * lane + 256 * j)); }
        }
        const float rs = rsqrtf(wave_sum(ss) * (1.f / 1024.f) + EPS) * scale;
        float s2 = 0.f;
#pragma unroll
        for (int j = 0; j < 4; ++j) { const f32x4 g = *(const f32x4*)(gpost + 4 * lane + 256 * j);
            x[j] = x[j] + f[j] * g * rs; __builtin_nontemporal_store(x[j], (f32x4*)(xr + 4 * lane + 256 * j));
            s2 += x[j][0] * x[j][0] + x[j][1] * x[j][1] + x[j][2] * x[j][2] + x[j][3] * x[j][3]; }
        if (gpre) {
            const float r2 = rsqrtf(wave_sum(s2) * (1.f / 1024.f) + EPS);
#pragma unroll
            for (int j = 0; j < 4; ++j) { const f32x4 g = *(const f32x4*)(gpre + 4 * lane + 256 * j);
                u32x2 w; w.x = cvt_pk_bf16(x[j][0] * r2 * g[0], x[j][1] * r2 * g[1]); w.y = cvt_pk_bf16(x[j][2] * r2 * g[2], x[j][3] * r2 * g[3]);
                *(u32x2*)(fr + 4 * lane + 256 * j) = w; }
        }
    }
}

template <bool NA>
__device__ __forceinline__ void attn_wave(bf16_t* PB, const bf16_t* KV, const float* rpb_h, int b, int hh, int r, int j, int qt, const bf16_t* VT, int lane, LAS float* RP) {
    constexpr int D = NA ? 64 : 128, NDC = D / 32, NDT = D / 16;
    const int c15 = lane & 15, g = lane >> 4;
    int rs = 0, bs = 0; size_t qtok; bf16_t* qp;
    if (NA) { qtok = (size_t)b * SEQ + r * 64 + 16 * j + c15; qp = PB + qtok * PC + hh * 64; rs = min(max(r - 4, 0), 120); bs = min(max(16 * j - 8, 0), 32); }
    else { qtok = (size_t)b * SEQ + qt * 16 + c15; qp = PB + qtok * PC + 2560 + hh * 128; }
    bf16x8 qf[NDC];
#pragma unroll
    for (int dc = 0; dc < NDC; ++dc) qf[dc] = *(const bf16x8*)(qp + 32 * dc + 8 * g);
    if (NA) {
#pragma unroll
        for (int i = 0; i < 8; ++i) { const int idx = lane + 64 * i; if (idx < 465) RP[idx] = rpb_h[idx]; }
        __builtin_amdgcn_wave_barrier();
    }
    f32x4 S[16];
#pragma unroll
    for (int kt = 0; kt < 16; ++kt) {
        const bf16_t* kp;
        if (NA) { const size_t ktok = (size_t)b * SEQ + (rs + (kt >> 1)) * 64 + bs + 16 * (kt & 1) + c15; kp = PB + ktok * PC + 512 + hh * 64; }
        else kp = KV + (size_t)(b * 256 + 16 * kt + c15) * 1024 + hh * 128;
        f32x4 acc = (f32x4){0.f, 0.f, 0.f, 0.f};
#pragma unroll
        for (int dc = 0; dc < NDC; ++dc) { const bf16x8 kf = *(const bf16x8*)(kp + 32 * dc + 8 * g); acc = __builtin_amdgcn_mfma_f32_16x16x32_bf16(kf, qf[dc], acc, 0, 0, 0); }
        S[kt] = acc;
    }
    const float scale = NA ? 0.125f : 0.08838834764831845f;
    float mx = -3.0e38f;
#pragma unroll
    for (int kt = 0; kt < 16; ++kt)
#pragma unroll
        for (int jj = 0; jj < 4; ++jj) {
            float s = S[kt][jj] * scale;
            if (NA) {
                const int kc = bs + 16 * (kt & 1) + 4 * g + jj, qc = 16 * j + c15, wsq = min(max(qc - 8, 0), 48);
                const bool valid = (kc >= wsq) && (kc < wsq + 16);
                const int dci = min(max(kc - qc, -15), 15) + 15, dri = rs + (kt >> 1) - r + 7;
                s = valid ? s + RP[dri * 31 + dci] : -1.0e30f;
            }
            S[kt][jj] = s; mx = fmaxf(mx, s);
        }
    mx = fmaxf(mx, __shfl_xor(mx, 16)); mx = fmaxf(mx, __shfl_xor(mx, 32));
    float sum = 0.f;
#pragma unroll
    for (int kt = 0; kt < 16; ++kt)
#pragma unroll
        for (int jj = 0; jj < 4; ++jj) { const float p = __expf(S[kt][jj] - mx); S[kt][jj] = p; sum += p; }
    sum += __shfl_xor(sum, 16); sum += __shfl_xor(sum, 32);
    const float inv = 1.0f / sum;
    f32x4 O[NDT];
#pragma unroll
    for (int dt = 0; dt < NDT; ++dt) O[dt] = (f32x4){0.f, 0.f, 0.f, 0.f};
#pragma unroll
    for (int kc8 = 0; kc8 < 8; ++kc8) {
        u32x4 pw; pw.x = cvt_pk_bf16(S[2 * kc8][0], S[2 * kc8][1]); pw.y = cvt_pk_bf16(S[2 * kc8][2], S[2 * kc8][3]);
        pw.z = cvt_pk_bf16(S[2 * kc8 + 1][0], S[2 * kc8 + 1][1]); pw.w = cvt_pk_bf16(S[2 * kc8 + 1][2], S[2 * kc8 + 1][3]);
        const bf16x8 pb = __builtin_bit_cast(bf16x8, pw);
#pragma unroll
        for (int dt = 0; dt < NDT; ++dt) {
            bf16x8 vf;
            if (NA) { const bf16_t* vp = VT + ((((size_t)(b * 8 + hh) * 128 + (rs + kc8)) * 64 + 16 * dt + c15) * 64) + bs + 4 * g;
                      const u32x2 p0 = *(const u32x2*)vp, p1 = *(const u32x2*)(vp + 16); u32x4 t; t.x = p0.x; t.y = p0.y; t.z = p1.x; t.w = p1.y; vf = __builtin_bit_cast(bf16x8, t); }
            else vf = *(const bf16x8*)(VT + (((size_t)(b * 4 + hh) * 128 + 16 * dt + c15) * 256) + 32 * kc8 + 8 * g);
            O[dt] = __builtin_amdgcn_mfma_f32_16x16x32_bf16(vf, pb, O[dt], 0, 0, 0);
        }
    }
#pragma unroll
    for (int dt = 0; dt < NDT; ++dt) { u32x2 w; w.x = cvt_pk_bf16(O[dt][0] * inv, O[dt][1] * inv); w.y = cvt_pk_bf16(O[dt][2] * inv, O[dt][3] * inv);
        *(u32x2*)(qp + 16 * dt + 4 * g) = w; }
}

constexpr int L_XC = 0, L_WA = 34816, L_HB = 38912, L_WL = 104448, L_CW = 122880, L_RP = 124416;
__device__ __forceinline__ void na_block(bf16_t* PB, const bf16_t* VT, const float* rpb_h, int b, int hh, int rp, LAS unsigned char* lds, int tid, bool fill_rp, u32x4 (&kpre)[9], bf16x8 (&qpre)[2], bool have, int nx) {
    const bool has_next = nx < 5120; const int nb = nx >> 9, nhh = nx & 7, nrp = (nx >> 3) & 63;
    const int lane = tid & 63, w = tid >> 6, c15 = lane & 15, g = lane >> 4;
    const int r = 2 * rp + (w >> 2), j = w & 3;
    const int rsU = min(max(2 * rp - 4, 0), 120), rs = min(max(r - 4, 0), 120), ro = rs - rsU, bs = min(max(16 * j - 8, 0), 32);
    LAS unsigned char* KS = lds;
    LAS float* RP = (LAS float*)(lds + L_RP + w * 2048);
    __syncthreads();
    if (!have) {
        { unsigned off = ((unsigned)(b * SEQ + rsU * 64 + (tid >> 3)) * (unsigned)PC + (unsigned)(512 + hh * 64 + 8 * (tid & 7))) * 2u;
#pragma unroll
          for (int i = 0; i < 9; ++i) { kpre[i] = (rsU + i) < 128 ? *(const u32x4*)((const char*)PB + off) : (u32x4){0u, 0u, 0u, 0u}; off += 64u * PC * 2u; } }
    }
#pragma unroll
    for (int i = 0; i < 9; ++i) { const int v = tid + 512 * i; *(LAS u32x4*)(KS + (v >> 3) * 144 + (v & 7) * 16) = kpre[i]; }
    if (fill_rp) {
#pragma unroll
        for (int i = 0; i < 8; ++i) { const int idx = lane + 64 * i; if (idx < 465) RP[idx] = 1.4426950408889634f * rpb_h[idx]; }
    }
    bf16_t* qp = PB + ((size_t)b * SEQ + r * 64 + 16 * j + c15) * PC + hh * 64;
    bf16x8 qf[2];
    if (!have) {
#pragma unroll
        for (int dc = 0; dc < 2; ++dc) qpre[dc] = *(const bf16x8*)(qp + 32 * dc + 8 * g);
    }
#pragma unroll
    for (int dc = 0; dc < 2; ++dc) qf[dc] = qpre[dc];
    __syncthreads();
    f32x4 S[16];
#pragma unroll
    for (int kt = 0; kt < 16; ++kt) {
        const int key = (ro + (kt >> 1)) * 64 + bs + 16 * (kt & 1) + c15;
        f32x4 acc = (f32x4){0.f, 0.f, 0.f, 0.f};
#pragma unroll
        for (int dc = 0; dc < 2; ++dc) { const bf16x8 kf = *(const LAS bf16x8*)(KS + key * 144 + (32 * dc + 8 * g) * 2); acc = __builtin_amdgcn_mfma_f32_16x16x32_bf16(kf, qf[dc], acc, 0, 0, 0); }
        S[kt] = acc;
        if ((kt & 3) == 3) asm volatile("" ::: "memory");
    }
    u32x4 vv[9];
    { unsigned off = ((unsigned)((((b * 8 + hh) * 128 + rsU) * 64 + (tid >> 3)) * 64) + (unsigned)(8 * (tid & 7))) * 2u;
#pragma unroll
      for (int i = 0; i < 9; ++i) { vv[i] = (rsU + i) < 128 ? *(const u32x4*)((const char*)VT + off) : (u32x4){0u, 0u, 0u, 0u}; off += 64u * 64u * 2u; } }
    float mx = -3.0e38f;
#pragma unroll
    for (int kt = 0; kt < 16; ++kt)
#pragma unroll
        for (int jj = 0; jj < 4; ++jj) {
            const int kc = bs + 16 * (kt & 1) + 4 * g + jj, qc = 16 * j + c15, wsq = min(max(qc - 8, 0), 48);
            const bool valid = (kc >= wsq) && (kc < wsq + 16);
            const int dci = min(max(kc - qc, -15), 15) + 15, dri = rs + (kt >> 1) - r + 7;
            const float sv = valid ? __builtin_fmaf(S[kt][jj], 0.125f * 1.4426950408889634f, RP[dri * 31 + dci]) : -1.0e30f;
            S[kt][jj] = sv; mx = fmaxf(mx, sv);
        }
    mx = fmaxf(mx, __shfl_xor(mx, 16)); mx = fmaxf(mx, __shfl_xor(mx, 32));
    float sum = 0.f;
#pragma unroll
    for (int kt = 0; kt < 16; ++kt)
#pragma unroll
        for (int jj = 0; jj < 4; ++jj) { const float p = __builtin_amdgcn_exp2f(S[kt][jj] - mx); S[kt][jj] = p; sum += p; }
    sum += __shfl_xor(sum, 16); sum += __shfl_xor(sum, 32);
    const float inv = 1.0f / sum;
    __syncthreads();
#pragma unroll
    for (int i = 0; i < 9; ++i) { const int v = tid + 512 * i; *(LAS u32x4*)(KS + (v >> 3) * 144 + (v & 7) * 16) = vv[i]; }
    if (has_next) {
        const int nrsU = min(max(2 * nrp - 4, 0), 120);
        { unsigned off = ((unsigned)(nb * SEQ + nrsU * 64 + (tid >> 3)) * (unsigned)PC + (unsigned)(512 + nhh * 64 + 8 * (tid & 7))) * 2u;
#pragma unroll
          for (int i = 0; i < 9; ++i) { kpre[i] = (nrsU + i) < 128 ? *(const u32x4*)((const char*)PB + off) : (u32x4){0u, 0u, 0u, 0u}; off += 64u * PC * 2u; } }
        const bf16_t* nqp = PB + ((size_t)nb * SEQ + (2 * nrp + (w >> 2)) * 64 + 16 * j + c15) * PC + nhh * 64;
#pragma unroll
        for (int dc = 0; dc < 2; ++dc) qpre[dc] = *(const bf16x8*)(nqp + 32 * dc + 8 * g);
    }
    __syncthreads();
    f32x4 O[4];
#pragma unroll
    for (int dt = 0; dt < 4; ++dt) O[dt] = (f32x4){0.f, 0.f, 0.f, 0.f};
#pragma unroll
    for (int kc8 = 0; kc8 < 8; ++kc8) {
        u32x4 pw; pw.x = cvt_pk_bf16(S[2 * kc8][0], S[2 * kc8][1]); pw.y = cvt_pk_bf16(S[2 * kc8][2], S[2 * kc8][3]);
        pw.z = cvt_pk_bf16(S[2 * kc8 + 1][0], S[2 * kc8 + 1][1]); pw.w = cvt_pk_bf16(S[2 * kc8 + 1][2], S[2 * kc8 + 1][3]);
        const bf16x8 pb = __builtin_bit_cast(bf16x8, pw);
#pragma unroll
        for (int dt = 0; dt < 4; ++dt) {
            const LAS unsigned char* vp = KS + ((ro + kc8) * 64 + 16 * dt + c15) * 144 + (bs + 4 * g) * 2;
            const u32x2 p0 = *(const LAS u32x2*)vp, p1 = *(const LAS u32x2*)(vp + 32);
            u32x4 t; t.x = p0.x; t.y = p0.y; t.z = p1.x; t.w = p1.y;
            O[dt] = __builtin_amdgcn_mfma_f32_16x16x32_bf16(__builtin_bit_cast(bf16x8, t), pb, O[dt], 0, 0, 0);
        }
        if (kc8 & 1) asm volatile("" ::: "memory");
    }
#pragma unroll
    for (int dt = 0; dt < 4; ++dt) { u32x2 wv; wv.x = cvt_pk_bf16(O[dt][0] * inv, O[dt][1] * inv); wv.y = cvt_pk_bf16(O[dt][2] * inv, O[dt][3] * inv);
        *(u32x2*)(qp + 16 * dt + 4 * g) = wv; }
}

__device__ __forceinline__ void ca_block(bf16_t* PB, const bf16_t* KV, const bf16_t* VT, int b, int hh, int q256, LAS unsigned char* lds, int tid, u32x4 (&pk)[8], u32x4 (&pv)[8], bool have, int nx) {
    const int lane = tid & 63, w = tid >> 6, c15 = lane & 15, g = lane >> 4;
    LAS unsigned char* Ks = lds;
    LAS unsigned char* Vs = lds + 69632;
    if (!have) {
        unsigned ok = ((unsigned)(b * 256 + (tid >> 4)) * 1024u + (unsigned)(hh * 128 + 8 * (tid & 15))) * 2u;
        unsigned ov = ((unsigned)((b * 4 + hh) * 128 + (tid >> 5)) * 256u + (unsigned)(8 * (tid & 31))) * 2u;
#pragma unroll
        for (int i = 0; i < 8; ++i) { pk[i] = *(const u32x4*)((const char*)KV + ok); ok += 32u * 1024u * 2u; }
#pragma unroll
        for (int i = 0; i < 8; ++i) { pv[i] = *(const u32x4*)((const char*)VT + ov); ov += 16u * 256u * 2u; }
    }
    __syncthreads();
#pragma unroll
    for (int i = 0; i < 8; ++i) { const int v = tid + 512 * i; *(LAS u32x4*)(Ks + (v >> 4) * 272 + (v & 15) * 16) = pk[i]; }
#pragma unroll
    for (int i = 0; i < 8; ++i) { const int v = tid + 512 * i; *(LAS u32x4*)(Vs + (v >> 5) * 528 + (v & 31) * 16) = pv[i]; }
    __syncthreads();
    if (nx < 1280) {
        const int nhh = nx & 3, nb = nx >> 7;
        unsigned ok = ((unsigned)(nb * 256 + (tid >> 4)) * 1024u + (unsigned)(nhh * 128 + 8 * (tid & 15))) * 2u;
        unsigned ov = ((unsigned)((nb * 4 + nhh) * 128 + (tid >> 5)) * 256u + (unsigned)(8 * (tid & 31))) * 2u;
#pragma unroll
        for (int i = 0; i < 8; ++i) { pk[i] = *(const u32x4*)((const char*)KV + ok); ok += 32u * 1024u * 2u; }
#pragma unroll
        for (int i = 0; i < 8; ++i) { pv[i] = *(const u32x4*)((const char*)VT + ov); ov += 16u * 256u * 2u; }
    }
#pragma unroll 1
    for (int round = 0; round < 2; ++round) {
        const int qt = q256 * 16 + round * 8 + w;
        bf16_t* qp = PB + ((size_t)b * SEQ + qt * 16 + c15) * PC + 2560 + hh * 128;
        bf16x8 qf[4];
#pragma unroll
        for (int dc = 0; dc < 4; ++dc) qf[dc] = *(const bf16x8*)(qp + 32 * dc + 8 * g);
        f32x4 S[16];
#pragma unroll
        for (int kt = 0; kt < 16; ++kt) {
            f32x4 acc = (f32x4){0.f, 0.f, 0.f, 0.f};
#pragma unroll
            for (int dc = 0; dc < 4; ++dc) { const bf16x8 kf = *(const LAS bf16x8*)(Ks + (16 * kt + c15) * 272 + (32 * dc + 8 * g) * 2); acc = __builtin_amdgcn_mfma_f32_16x16x32_bf16(kf, qf[dc], acc, 0, 0, 0); }
            S[kt] = acc;
            if (kt & 1) asm volatile("" ::: "memory");
        }
        float mx = -3.0e38f;
#pragma unroll
        for (int kt = 0; kt < 16; ++kt)
#pragma unroll
            for (int jj = 0; jj < 4; ++jj) { const float sv = S[kt][jj] * (0.08838834764831845f * 1.4426950408889634f); S[kt][jj] = sv; mx = fmaxf(mx, sv); }
        mx = fmaxf(mx, __shfl_xor(mx, 16)); mx = fmaxf(mx, __shfl_xor(mx, 32));
        float sum = 0.f;
#pragma unroll
        for (int kt = 0; kt < 16; ++kt)
#pragma unroll
            for (int jj = 0; jj < 4; ++jj) { const float p = __builtin_amdgcn_exp2f(S[kt][jj] - mx); S[kt][jj] = p; sum += p; }
        sum += __shfl_xor(sum, 16); sum += __shfl_xor(sum, 32);
        const float inv = 1.0f / sum;
        f32x4 O[8];
#pragma unroll
        for (int dt = 0; dt < 8; ++dt) O[dt] = (f32x4){0.f, 0.f, 0.f, 0.f};
#pragma unroll
        for (int kc8 = 0; kc8 < 8; ++kc8) {
            u32x4 pw; pw.x = cvt_pk_bf16(S[2 * kc8][0], S[2 * kc8][1]); pw.y = cvt_pk_bf16(S[2 * kc8][2], S[2 * kc8][3]);
            pw.z = cvt_pk_bf16(S[2 * kc8 + 1][0], S[2 * kc8 + 1][1]); pw.w = cvt_pk_bf16(S[2 * kc8 + 1][2], S[2 * kc8 + 1][3]);
            const bf16x8 pb = __builtin_bit_cast(bf16x8, pw);
#pragma unroll
            for (int dt = 0; dt < 8; ++dt) { const bf16x8 vf = *(const LAS bf16x8*)(Vs + (16 * dt + c15) * 528 + (32 * kc8 + 8 * g) * 2); O[dt] = __builtin_amdgcn_mfma_f32_16x16x32_bf16(vf, pb, O[dt], 0, 0, 0); }
            asm volatile("" ::: "memory");
        }
#pragma unroll
        for (int dt = 0; dt < 8; ++dt) { u32x2 wv; wv.x = cvt_pk_bf16(O[dt][0] * inv, O[dt][1] * inv); wv.y = cvt_pk_bf16(O[dt][2] * inv, O[dt][3] * inv);
            *(u32x2*)(qp + 16 * dt + 4 * g) = wv; }
    }
}

constexpr int LSEG = 512, NSEG = SEQ / LSEG;
__device__ __forceinline__ void lru_item(const Ctx& a, LAS unsigned char* lds, int l, int b, int n, int seg, int pass, const int tid) {
    const int lane = tid & 63, w = tid >> 6, c15 = lane & 15, g = lane >> 4;
    unsigned char* ws = a.ws();
    bf16_t* PB = (bf16_t*)(ws + WS_B); float* AGG = (float*)(ws + WS_AGG);
    const bf16_t* LW = (const bf16_t*)(ws + WS_W) + (size_t)l * WL + OFF_LRU;
    const int cb = 64 * n; const size_t tok0 = (size_t)b * SEQ;
    LAS float* XC = (LAS float*)(lds + L_XC);
    LAS float* WA = (LAS float*)(lds + L_WA);
    LAS bf16_t* HB = (LAS bf16_t*)(lds + L_HB);
    LAS unsigned char* WLs = lds + L_WL;
    LAS float* CWs = (LAS float*)(lds + L_CW);
    LAS float* AGs = (LAS float*)(lds + L_RP);
    const float* cw = a.in(11) + (size_t)l * 4 * 512 + cb; const float* cbias = a.in(12) + (size_t)l * 512 + cb;
    const int cg8 = tid & 7;
    u32x4 wpre[2]; f32x4 agpre = (f32x4){0.f, 0.f, 0.f, 0.f};
    LAS float* CPs = (LAS float*)(lds + 133120);
    u32x4 xr[2][4];
    auto load_consts = [&](int d) {
        const bf16_t* Wsrc = LW + ((size_t)(d * 2) * 8 + n) * 4096;
#pragma unroll
        for (int i = 0; i < 2; ++i) { const int v = tid + 512 * i, mat = v >> 9, row = (v >> 3) & 63, c8 = v & 7; wpre[i] = *(const u32x4*)(Wsrc + (size_t)mat * 8 * 4096 + row * 64 + 8 * c8); }
        if (pass == 1) agpre = *(const f32x4*)(AGG + ((size_t)((b * 8 + n) * 2 + d) * NSEG) * 128 + 4 * tid);
    };
    auto load_x = [&](int dir, int c) {
        const int tl0n = dir ? LSEG - 128 * (c + 1) : 128 * c; const int t0n = seg * LSEG + tl0n;
        const bool interior = (t0n >= 2) && (t0n + 130 <= SEQ);
#pragma unroll
        for (int rep = 0; rep < 2; ++rep) { const int tokl = (tid + 512 * rep) >> 3;
            const int ts0 = t0n + tokl - 2;
            unsigned off = ((unsigned)((int)tok0 + ts0) * (unsigned)PC + (unsigned)(1536 + cb + 8 * cg8)) * 2u;
            if (interior) {
#pragma unroll
                for (int tap = 0; tap < 4; ++tap) { xr[rep][tap] = *(const u32x4*)((const char*)PB + off); off += PC * 2; }
            } else {
#pragma unroll
                for (int tap = 0; tap < 4; ++tap) { const int ts = ts0 + tap;
                    xr[rep][tap] = (ts >= 0 && ts < SEQ) ? *(const u32x4*)((const char*)PB + off) : (u32x4){0u, 0u, 0u, 0u}; off += PC * 2; }
            } }
    };
    load_consts(1); load_x(1, 0);
    if (tid < 320) CWs[tid] = tid < 256 ? cw[(tid >> 6) * 512 + (tid & 63)] : cbias[tid - 256];
    if (tid >= 384) { const int d = (tid - 384) >> 6, chl = tid & 63, ch = (l * 2 + d) * 512 + cb + chl;
        const float lam = a.in(17)[ch];
        CPs[d * 192 + chl] = -1.4426950408889634f * a.in(14)[ch]; CPs[d * 192 + 64 + chl] = -1.4426950408889634f * a.in(16)[ch];
        CPs[d * 192 + 128 + chl] = -8.0f * 1.4426950408889634f * ((lam > 15.f) ? __expf(-lam) : log1pf(__expf(-lam))); }
#pragma unroll
    for (int sweep = 0; sweep < 2; ++sweep) {
        const int dir = 1 - sweep;
#pragma unroll
        for (int i = 0; i < 2; ++i) { const int v = tid + 512 * i, mat = v >> 9, row = (v >> 3) & 63, c8 = v & 7; *(LAS u32x4*)(WLs + mat * 9216 + row * 144 + c8 * 16) = wpre[i]; }
        if (pass == 1) *(LAS f32x4*)(AGs + 4 * tid) = agpre;
        float ba[4], bi[4], sp[4], hin[4], ain[4];
#pragma unroll
        for (int nt = 0; nt < 4; ++nt) { hin[nt] = 0.f; ain[nt] = 1.f; }
        __syncthreads();
#pragma unroll
        for (int nt = 0; nt < 4; ++nt) { ba[nt] = CPs[dir * 192 + 16 * nt + c15]; bi[nt] = CPs[dir * 192 + 64 + 16 * nt + c15]; sp[nt] = CPs[dir * 192 + 128 + 16 * nt + c15]; }
        if (pass == 1) {
#pragma unroll
            for (int nt = 0; nt < 4; ++nt) { float h0 = 0.f;
                if (dir == 0) { for (int s2 = 0; s2 < seg; ++s2) { const LAS float* q = AGs + s2 * 128 + (16 * nt + c15) * 2; h0 = q[0] * h0 + q[1]; } }
                else { for (int s2 = NSEG - 1; s2 > seg; --s2) { const LAS float* q = AGs + s2 * 128 + (16 * nt + c15) * 2; h0 = q[0] * h0 + q[1]; } }
                hin[nt] = h0; }
        }
        for (int c = 0; c < LSEG / 128; ++c) {
            const int tl0 = dir ? LSEG - 128 * (c + 1) : 128 * c;
#pragma unroll
            for (int rep = 0; rep < 2; ++rep) {
                const int tokl = (tid + 512 * rep) >> 3, i = dir ? 127 - tokl : tokl;
                f32x4 o0 = *(const LAS f32x4*)(CWs + 256 + 8 * cg8), o1 = *(const LAS f32x4*)(CWs + 256 + 8 * cg8 + 4);
#pragma unroll
                for (int tap = 0; tap < 4; ++tap) {
                    const u32x4 xv = xr[rep][tap];
                    const f32x4 w0 = *(const LAS f32x4*)(CWs + tap * 64 + 8 * cg8), w1 = *(const LAS f32x4*)(CWs + tap * 64 + 8 * cg8 + 4);
                    o0[0] += bflo(xv.x) * w0[0]; o0[1] += bfhi(xv.x) * w0[1]; o0[2] += bflo(xv.y) * w0[2]; o0[3] += bfhi(xv.y) * w0[3];
                    o1[0] += bflo(xv.z) * w1[0]; o1[1] += bfhi(xv.z) * w1[1]; o1[2] += bflo(xv.w) * w1[2]; o1[3] += bfhi(xv.w) * w1[3];
                }
                *(LAS f32x4*)(XC + i * 68 + 8 * cg8) = o0;
                *(LAS f32x4*)(XC + i * 68 + 8 * cg8 + 4) = o1;
            }
            if (c + 1 < LSEG / 128) load_x(dir, c + 1);
            bf16_t gq[4][4];
            const unsigned gbase = ((unsigned)((int)tok0 + seg * LSEG + tl0 + 16 * w + 4 * g) * (unsigned)PC + (unsigned)(2048 + cb + c15)) * 2u;
            if (pass == 1 && sweep == 1) {
#pragma unroll
                for (int nt = 0; nt < 4; ++nt)
#pragma unroll
                    for (int jj = 0; jj < 4; ++jj) gq[nt][jj] = *(const bf16_t*)((const char*)PB + gbase + (unsigned)(jj * PC * 2 + nt * 32));
            }
            __syncthreads();
            bf16x8 Af[2];
#pragma unroll
            for (int kc = 0; kc < 2; ++kc) { const f32x4 x0 = *(const LAS f32x4*)(XC + (16 * w + c15) * 68 + 32 * kc + 8 * g), x1 = *(const LAS f32x4*)(XC + (16 * w + c15) * 68 + 32 * kc + 8 * g + 4);
                u32x4 pw; pw.x = cvt_pk_bf16(x0[0], x0[1]); pw.y = cvt_pk_bf16(x0[2], x0[3]); pw.z = cvt_pk_bf16(x1[0], x1[1]); pw.w = cvt_pk_bf16(x1[2], x1[3]); Af[kc] = __builtin_bit_cast(bf16x8, pw); }
            float hl[4][4], pc[4][4], eA[4], eH[4];
#pragma unroll
            for (int nt = 0; nt < 4; ++nt) {
                f32x4 pr = (f32x4){0.f, 0.f, 0.f, 0.f}, pi = pr;
#pragma unroll
                for (int kc = 0; kc < 2; ++kc) {
                    const bf16x8 wa8 = *(const LAS bf16x8*)(WLs + (16 * nt + c15) * 144 + (32 * kc + 8 * g) * 2), wi8 = *(const LAS bf16x8*)(WLs + 9216 + (16 * nt + c15) * 144 + (32 * kc + 8 * g) * 2);
                    pr = __builtin_amdgcn_mfma_f32_16x16x32_bf16(Af[kc], wa8, pr, 0, 0, 0); pi = __builtin_amdgcn_mfma_f32_16x16x32_bf16(Af[kc], wi8, pi, 0, 0, 0); }
                float hp = 0.f, pp = 1.f;
#pragma unroll
                for (int jj = 0; jj < 4; ++jj) {
                    const float rg = __builtin_amdgcn_rcpf(1.0f + __builtin_amdgcn_exp2f(__builtin_fmaf(pr[jj], -1.4426950408889634f, ba[nt])));
                    const float ig = __builtin_amdgcn_rcpf(1.0f + __builtin_amdgcn_exp2f(__builtin_fmaf(pi[jj], -1.4426950408889634f, bi[nt])));
                    const float av = __builtin_amdgcn_exp2f(rg * sp[nt]); const float mu = __builtin_amdgcn_sqrtf(fmaxf(__builtin_fmaf(-av, av, 1.0f), 0.f));
                    const float xv = XC[(16 * w + 4 * g + jj) * 68 + 16 * nt + c15];
                    const float uv = mu * ig * xv;
                    hp = av * hp + uv; pp = av * pp; hl[nt][jj] = hp; pc[nt][jj] = pp;
                }
                float iA = pp, iH = hp;
                float tA = __shfl_up(iA, 16), tH = __shfl_up(iH, 16); if (g >= 1) { iH = iA * tH + iH; iA = iA * tA; }
                tA = __shfl_up(iA, 32); tH = __shfl_up(iH, 32); if (g >= 2) { iH = iA * tH + iH; iA = iA * tA; }
                float xA = __shfl_up(iA, 16), xH = __shfl_up(iH, 16); if (g == 0) { xA = 1.f; xH = 0.f; }
                eA[nt] = xA; eH[nt] = xH;
                if (g == 3) { WA[(w * 64 + 16 * nt + c15) * 2] = iA; WA[(w * 64 + 16 * nt + c15) * 2 + 1] = iH; }
            }
            if (c + 1 == LSEG / 128 && sweep == 0) { load_consts(0); load_x(0, 0); }
            __syncthreads();
#pragma unroll
            for (int nt = 0; nt < 4; ++nt) {
                float cwv = hin[nt], cin = 0.f, ap = ain[nt];
#pragma unroll
                for (int w2 = 0; w2 < 8; ++w2) { const float A2 = WA[(w2 * 64 + 16 * nt + c15) * 2], H2 = WA[(w2 * 64 + 16 * nt + c15) * 2 + 1]; if (w2 == w) cin = cwv; cwv = A2 * cwv + H2; ap *= A2; }
                hin[nt] = cwv; ain[nt] = ap;
                if (pass == 1) {
                    const float cl = eA[nt] * cin + eH[nt];
#pragma unroll
                    for (int jj = 0; jj < 4; ++jj) {
                        const float hv = pc[nt][jj] * cl + hl[nt][jj];
                        const int i = 16 * w + 4 * g + jj, tl = tl0 + (dir ? 127 - i : i); const int ch = 16 * nt + c15;
                        if (sweep == 0) { HB[tl * 64 + ch] = (bf16_t)(cvt_pk_bf16(hv, 0.f) & 0xffffu); }
                        else { const float hb = bf2f(HB[tl * 64 + ch]); const float gl = bf2f(gq[nt][jj]);
                               *(bf16_t*)((char*)PB + gbase + (unsigned)(jj * PC * 2 + nt * 32)) = (bf16_t)(cvt_pk_bf16((hv + hb) * gelu_tanh(gl), 0.f) & 0xffffu); }
                    }
                }
            }
        }
        if (pass == 0 && w == 0 && g == 0) {
            float* q = AGG + ((size_t)((b * 8 + n) * 2 + dir) * NSEG + seg) * 128;
#pragma unroll
            for (int nt = 0; nt < 4; ++nt) { __hip_atomic_store(q + (16 * nt + c15) * 2, ain[nt], __ATOMIC_RELAXED, __HIP_MEMORY_SCOPE_AGENT); __hip_atomic_store(q + (16 * nt + c15) * 2 + 1, hin[nt], __ATOMIC_RELAXED, __HIP_MEMORY_SCOPE_AGENT); }
        }
        __syncthreads();
    }
}

__device__ __forceinline__ void mixer_phase(const Ctx& a, LAS unsigned char* lds, int l, int pass) {
    const int tid = a.tid;
    bf16_t* PB = (bf16_t*)(a.ws() + WS_B);
    const bf16_t* KV = (const bf16_t*)(a.ws() + WS_KVB) + (size_t)l * 2560 * 1024;
    constexpr int N_LRU = 80 * NSEG, N_NA = 5120, N_CA = 1280;
    const int G = (int)gridDim.x;
    for (int it = blockIdx.x; it < N_LRU; it += G) {
        int t2 = tid; asm volatile("" : "+v"(t2));
#ifndef SKIP_LRU
        lru_item(a, lds, l, it / (8 * NSEG), (it / NSEG) & 7, it % NSEG, pass, t2);
        __syncthreads();
#endif
    }
    if (pass == 0) {
        { int x0 = ((int)blockIdx.x - N_LRU) % G; if (x0 < 0) x0 += G;
          u32x4 kpre[9]; bf16x8 qpre[2];
          for (int x = x0; x < N_NA; x += G) {
              int t2 = tid; asm volatile("" : "+v"(t2));
              const int hh = x & 7, rp = (x >> 3) & 63, b = x >> 9;
#ifndef SKIP_NA
              na_block(PB, (const bf16_t*)(a.ws() + WS_S), a.in(10) + (size_t)(l * 8 + hh) * 465, b, hh, rp, lds, t2, (x == x0) || (gridDim.x & 7u), kpre, qpre, x != x0, x + G);
#endif
          } }
        { int x0 = ((int)blockIdx.x - N_LRU - N_NA) % G; if (x0 < 0) x0 += G;
          u32x4 pk[8], pv[8];
          for (int x = x0; x < N_CA; x += G) {
              int t2 = tid; asm volatile("" : "+v"(t2));
              const int hh = x & 3, q256 = (x >> 2) & 31, b = x >> 7;
#ifndef SKIP_CA
              ca_block(PB, KV, (const bf16_t*)(a.ws() + WS_VTC) + (size_t)l * 10 * 4 * 128 * 256, b, hh, q256, lds, t2, pk, pv, x != x0, x + G);
#endif
          } }
    }
    __syncthreads();
}

#define XB_TMO      128
#define XB_XCNT(j)  (256  + 64 * (j))
#define XB_XSUB(j)  (1280 + 64 * (j))
#define XB_XGEN(j)  (2304 + 64 * (j))
#define XB_TOP      3328
#define XB_TOPGEN   3392
#define XCD_BAR_WORDS 3456
#define XB_SPIN_CAP (1u << 22)
__device__ __forceinline__ unsigned xb_ld(unsigned* p)              { return __hip_atomic_load(p, __ATOMIC_RELAXED, __HIP_MEMORY_SCOPE_AGENT); }
__device__ __forceinline__ unsigned xb_add(unsigned* p, unsigned v) { return __hip_atomic_fetch_add(p, v, __ATOMIC_RELAXED, __HIP_MEMORY_SCOPE_AGENT); }
__device__ __forceinline__ unsigned xb_xcc_id() { return (unsigned)__builtin_amdgcn_s_getreg((3 << 11) | 20) & 0xFu; }
#define XB_SPIN(cond, bar) do { unsigned _sp = 0; while (cond) { __builtin_amdgcn_s_sleep(1); \
    if ((++_sp & 255u) == 0u) { if (xb_ld(&(bar)[XB_TMO])) break; if (_sp > XB_SPIN_CAP) { atomicAdd(&(bar)[XB_TMO], 1u); break; } } } } while (0)
struct XcdBarrier { unsigned* bar; unsigned x; volatile LAS unsigned* st; };
__device__ __forceinline__ XcdBarrier xcd_barrier_post(unsigned* bar, volatile LAS unsigned* st) {
    XcdBarrier b; b.bar = bar; b.x = xb_xcc_id(); b.st = st;
    if (threadIdx.x == 0) (void)xb_add(&bar[XB_XCNT(b.x)], 1u);
    return b;
}
__device__ __forceinline__ void xcd_barrier_complete(unsigned* bar, unsigned x, unsigned& nloc, unsigned& nx) {
    const unsigned G = gridDim.x * gridDim.y * gridDim.z;
    unsigned sum, cnt, mine, sp = 0u;
    for (;;) {
        sum = 0u; cnt = 0u; mine = 0u;
#pragma unroll
        for (unsigned j = 0; j < 16; ++j) { const unsigned c = xb_ld(&bar[XB_XCNT(j)]); sum += c; cnt += (c > 0u) ? 1u : 0u; mine = (j == x) ? c : mine; }
        if (sum == G) break;
        __builtin_amdgcn_s_sleep(1);
        if ((++sp & 255u) == 0u) { if (xb_ld(&bar[XB_TMO])) break; if (sp > XB_SPIN_CAP) { atomicAdd(&bar[XB_TMO], 1u); break; } }
    }
    nloc = mine > 0u ? mine : 1u; nx = cnt > 0u ? cnt : 1u;
}
__device__ __forceinline__ void xcd_barrier(const XcdBarrier& b) {
    asm volatile("s_waitcnt vmcnt(0)" ::: "memory");
    __syncthreads();
    if (threadIdx.x == 0) {
        unsigned* bar = b.bar;
        __builtin_amdgcn_s_waitcnt(0);
        unsigned nloc = b.st[0], nx = b.st[1];
        if (nloc == 0u) { xcd_barrier_complete(bar, b.x, nloc, nx); b.st[0] = nloc; b.st[1] = nx; }
        const unsigned old = xb_add(&bar[XB_XSUB(b.x)], 1u);
        const unsigned gen = old / nloc;
        if (old + 1u == (gen + 1u) * nloc) {
            __builtin_amdgcn_fence(__ATOMIC_RELEASE, "agent");
            asm volatile("s_waitcnt vmcnt(0)" ::: "memory");
            const unsigned og = xb_add(&bar[XB_TOP], 1u);
            const unsigned tg = og / nx;
            if (og + 1u == (tg + 1u) * nx) xb_add(&bar[XB_TOPGEN], 1u);
            else XB_SPIN(xb_ld(&bar[XB_TOPGEN]) == tg, bar);
            __builtin_amdgcn_fence(__ATOMIC_ACQUIRE, "agent");
            xb_add(&bar[XB_XGEN(b.x)], 1u);
            asm volatile("s_waitcnt vmcnt(0)" ::: "memory");
        } else {
            XB_SPIN(xb_ld(&bar[XB_XGEN(b.x)]) == gen, bar);
            __builtin_amdgcn_fence(__ATOMIC_ACQUIRE, "agent");
            asm volatile("s_waitcnt vmcnt(0)" ::: "memory");
        }
    }
    __syncthreads();
}

constexpr int NPL = 12, NPH = 2 + NPL * NL;
__global__ void __launch_bounds__(512, 2) mega(Args args) {
    extern __shared__ __attribute__((aligned(16))) unsigned char lds_raw[];
    LAS unsigned char* lds = (LAS unsigned char*)lds_raw;
    cg::grid_group grid = cg::this_grid();
    Ctx a; a.tab = (LAS unsigned long long*)(lds + 141000);
    { const unsigned long long* ka = (const unsigned long long*)__builtin_amdgcn_kernarg_segment_ptr();
      if (threadIdx.x < 33) a.tab[threadIdx.x] = ka[threadIdx.x];
      if (threadIdx.x == 64) { ((LAS unsigned*)(lds + 141500))[0] = 0u; ((LAS unsigned*)(lds + 141500))[1] = 0u; } }
    __syncthreads();
    XcdBarrier xbar = xcd_barrier_post((unsigned*)(args.ws + WS_CTL), (volatile LAS unsigned*)(lds + 141500));
    const int ph_lo = args.ph_lo, ph_hi = args.ph_hi;
    for (int ph = ph_lo; ph < ph_hi; ++ph) {
        if (ph > ph_lo) { if (ph == ph_lo + 1) grid.sync(); else xcd_barrier(xbar); }
        int tid = threadIdx.x; asm volatile("" : "+v"(tid));
        a.tid = tid;
        const int G = gridDim.x, c = blockIdx.x;
        unsigned char* ws = a.ws();
        const char* Wb = (const char*)(ws + WS_W);
        bf16_t* bufA = (bf16_t*)(ws + WS_A); bf16_t* bufB = (bf16_t*)(ws + WS_B);
        if (ph == 0) {
#ifndef SKIP_P0
            p0_prologue(a, lds);
#endif
            continue; }
        const int l = ph >= 2 ? (ph - 2) / NPL : 0, s = ph >= 2 ? (ph - 2) % NPL : -1;
        const char* WLc = Wb + (size_t)l * WL * 2;
        if (s == 2 || s == 8 || s == 11) {
            const float* gpost = a.in(s == 2 ? 7 : (s == 8 ? 26 : 30)) + l * 1024;
            const float* gpre = s == 2 ? a.in(8) + l * 1024 : (s == 8 ? a.in(27) + l * 1024 : (l + 1 < NL ? a.in(4) + (l + 1) * 1024 : nullptr));
#ifndef SKIP_E
            e_phase(a, a.out(), bufA, gpost, s == 8 ? 1.0f : 0.5f, gpre);
#endif
            continue;
        }
        if (s == 4 || s == 5) {
#ifndef SKIP_MIX
            mixer_phase(a, lds, l, s - 4);
#endif
            continue;
        }
        USched S; UEpi E;
        S.kind = 0; S.Wg = nullptr; S.Wbr = nullptr; S.PB = nullptr; E.kind = 0; E.bgate = nullptr; E.park = nullptr; E.O = bufA; E.ldc = 1024; E.vt = 0; E.VT = nullptr;
        S.A = (const char*)bufA; S.lda = 2048; S.B = WLc; S.ldb = 2048; S.nt = 16;
        if (ph == 1) { S.kind = 1; S.o.G = G; S.o.c = c; S.o.nM = 0; S.o.nN = 0; S.o.nwg = 0; S.A = (const char*)(ws + WS_B); S.B = Wb; E.O = (bf16_t*)(ws + WS_KVB); E.ldc = 1024; E.vt = 2; E.VT = (bf16_t*)(ws + WS_VTC); }
        else if (s == 0 || s == 9) { S.o.init(T, 5632, G, c); S.B = WLc + (s == 0 ? OFF_UP1 : OFF_UP2) * 2; E.kind = 1; E.O = bufB; E.ldc = DFF; }
        else if (s == 1 || s == 10) { S.o.init(T, 1024, G, c); S.A = (const char*)bufB; S.lda = DFF * 2; S.B = WLc + (s == 1 ? OFF_DN1 : OFF_DN2) * 2; S.ldb = DFF * 2; S.nt = 44; }
        else if (s == 3) { S.o.init(T, 3072, G, c); S.B = WLc + OFF_IN * 2; E.O = bufB; E.ldc = PC; E.vt = 1; E.VT = (bf16_t*)(ws + WS_S); }
        else if (s == 7) { S.o.init(T, 1024, G, c); S.A = (const char*)(bufB + 512); S.lda = PC * 2; S.B = WLc + OFF_OUT * 2; }
        else {
            S.kind = 2; S.o.init(T, 1024, G, c); S.PB = (const char*)bufB; S.Wg = WLc + OFF_GATE * 2; S.Wbr = WLc + OFF_BR * 2;
            E.kind = 2; E.O = bufB + 512; E.ldc = PC; E.bgate = a.in(21) + (size_t)l * 3072; E.park = (u32x4*)(ws + WS_S) + (size_t)c * 16 * 512;
        }
#ifndef SKIP_GEMM
        pg8::gemm_phase<UEpi, USched>(lds, tid, S, E);
#endif
    }
}

extern "C" void kernel_launch(void* const* d_in, const int* in_sizes, int n_in, void* d_out, int out_size, void* d_ws, size_t ws_size, hipStream_t stream) {
    static int grid = 0;
    if (grid == 0) {
        if (n_in != 31 || ws_size < WS_END || out_size != T * 1024) { fprintf(stderr, "kernel_launch: unexpected shapes (n_in %d, out %d, ws %zu)\n", n_in, out_size, ws_size); grid = -1; return; }
        int dev = 0, cus = 0, per_cu = 0;
        hipGetDevice(&dev); hipDeviceGetAttribute(&cus, hipDeviceAttributeMultiprocessorCount, dev);
        hipFuncSetAttribute((const void*)mega, hipFuncAttributeMaxDynamicSharedMemorySize, LDS_BYTES);
        hipOccupancyMaxActiveBlocksPerMultiprocessor(&per_cu, (const void*)mega, 512, LDS_BYTES);
        if (per_cu < 1) per_cu = 1;
        (void)hipGetLastError();
        grid = cus * per_cu;
    }
    if (grid < 0) return;
    hipMemsetAsync((char*)d_ws + WS_CTL, 0, 16384, stream);
    Args a{};
    for (int i = 0; i < 31; ++i) a.in[i] = (const float*)d_in[i];
    a.out = (float*)d_out; a.ws = (unsigned char*)d_ws;
#if MULTI_LAUNCH
    for (int ph = 0; ph < NPH; ++ph) { a.ph_lo = ph; a.ph_hi = ph + 1; hipLaunchKernelGGL(mega, dim3(grid), dim3(512), LDS_BYTES, stream, a); }
#else
    a.ph_lo = 0; a.ph_hi = NPH;
    void* args[] = {&a};
    hipError_t e = hipLaunchCooperativeKernel((const void*)mega, dim3(grid), dim3(512), args, LDS_BYTES, stream);
    if (e != hipSuccess) fprintf(stderr, "cooperative launch failed: %s (grid %d)\n", hipGetErrorString(e), grid);
#endif
}
```

```cpp
#include <hip/hip_runtime.h>
#include <hip/hip_cooperative_groups.h>
#include <cstdio>
#include <cstdint>
namespace cg = cooperative_groups;

#ifndef MULTI_LAUNCH
#define MULTI_LAUNCH 0
#endif

#define LAS __attribute__((address_space(3)))
typedef unsigned short bf16_t;
typedef short bf16x8 __attribute__((ext_vector_type(8)));
typedef float f32x4 __attribute__((ext_vector_type(4)));
typedef unsigned u32x4 __attribute__((ext_vector_type(4)));
typedef unsigned u32x2 __attribute__((ext_vector_type(2)));

constexpr int T = 81920, SEQ = 8192, NBAT = 10, NL = 4, DFF = 2816;
constexpr int PC = 3072;
constexpr float EPS = 1e-6f;

constexpr size_t WL = 27394048;
constexpr size_t OFF_UP1 = 0, OFF_DN1 = 5767168, OFF_UP2 = 8650752, OFF_DN2 = 14417920, OFF_IN = 17301504,
                 OFF_GATE = 20447232, OFF_BR = 23592960, OFF_OUT = 25165824, OFF_KV = 26214400, OFF_LRU = 27262976;
constexpr size_t WS_CTL = 0;
constexpr size_t WS_AGG = 65536;
constexpr size_t WS_W = 3u << 20;
constexpr size_t WS_KVB = WS_W + 4 * WL * 2;
constexpr size_t WS_A = WS_KVB + (size_t)4 * 2560 * 1024 * 2;
constexpr size_t WS_B = WS_A + (size_t)T * 1024 * 2;
constexpr size_t WS_S = WS_B + (size_t)T * 3072 * 2;
constexpr size_t WS_VTC = WS_S + (size_t)T * 512 * 2;
constexpr size_t WS_END = WS_VTC + (size_t)4 * 10 * 4 * 128 * 256 * 2;
static_assert(WS_END <= (size_t)1 << 30, "workspace");
constexpr int LDS_BYTES = 147456;

typedef float f32x2_t __attribute__((ext_vector_type(2)));
typedef __bf16 bf16x2_t __attribute__((ext_vector_type(2)));
__device__ __forceinline__ unsigned cvt_pk_bf16(float lo, float hi) { const f32x2_t v = {lo, hi}; const bf16x2_t b = __builtin_convertvector(v, bf16x2_t); return __builtin_bit_cast(unsigned, b); }
__device__ __forceinline__ float bflo(unsigned w) { return __uint_as_float(w << 16); }
__device__ __forceinline__ float bfhi(unsigned w) { return __uint_as_float(w & 0xffff0000u); }
__device__ __forceinline__ float bf2f(bf16_t v) { return __uint_as_float((unsigned)v << 16); }
__device__ __forceinline__ float sigmoidf_(float x) { return __builtin_amdgcn_rcpf(1.0f + __expf(-x)); }
__device__ __forceinline__ float wave_sum(float v) {
#pragma unroll
    for (int o = 1; o < 64; o <<= 1) v += __shfl_xor(v, o);
    return v;
}
__device__ __forceinline__ float gelu_tanh(float x) {
    const float t = __builtin_fmaf(x * x, 2.302208198f * 0.044715f, 2.302208198f);
    const float r = __builtin_amdgcn_rcpf(__builtin_amdgcn_exp2f(x * t) + 1.0f);
    return __builtin_fmaf(-x, r, x);
}

namespace pg8 {
constexpr int BM = 256, BK = 64, HALF = 128, HTB = HALF * BK * 2, STAGE_BYTES = 8 * HTB, NXCD = 8, WGM = 8;
__host__ __device__ __forceinline__ int lds_byte(int r, int c) { const int st = (r >> 4) * 2 + (c >> 5), rr = r & 15, cc = c & 31, ob = rr * 64 + cc * 2; return st * 1024 + (ob ^ (((ob >> 9) & 1) << 5)); }
__host__ __device__ __forceinline__ void stage_rc(int b, int& R, int& C) { const int st = b / 1024, sb = b % 1024, swz = sb ^ (((sb >> 9) & 1) << 5); R = (st >> 1) * 16 + swz / 64; C = (st & 1) * 32 + (swz % 64) / 2; }
__host__ __device__ __forceinline__ int perm32(int rho) { const int n = rho >> 4, i = rho & 15; return 8 * (i >> 2) + 4 * n + (i & 3); }

struct Unit { const char* A; const char* B; int lda, ldb, nt, pm, pn, sub; };

struct StaticOrder {
    int nM, nN, nwg, G, c;
    __device__ void init(int M, int N, int G_, int c_) { nM = M / BM; nN = N / BM; nwg = nM * nN; G = G_; c = c_; }
    __device__ bool next(int i, int& pm, int& pn) const {
        const long L = (long)i * G + c; if (__builtin_amdgcn_readfirstlane((int)(L >= nwg))) return false;
        int wgid = (int)L; { const int q = nwg / NXCD, r = nwg % NXCD, xcd = wgid % NXCD, off = wgid / NXCD; wgid = (xcd < r ? xcd * (q + 1) : r * (q + 1) + (xcd - r) * q) + off; }
        const int nig = WGM * nN, gid = wgid / nig, t = wgid - gid * nig, fm = gid * WGM, gsz = (nM - fm) < WGM ? (nM - fm) : WGM;
        int pm_, pn_;
        if (gsz == WGM) { pm_ = fm + (t & (WGM - 1)); pn_ = t >> 3; }
        else { pm_ = fm + t % gsz; pn_ = t / gsz; }
        pm = __builtin_amdgcn_readfirstlane(pm_); pn = __builtin_amdgcn_readfirstlane(pn_); return true;
    }
};

template <class Epi, class Sched>
__device__ __forceinline__ void gemm_phase(LAS unsigned char* lds, const int tid, const Sched& S, const Epi& E) {
    const int wid = __builtin_amdgcn_readfirstlane(tid >> 6), lane = tid & 63, wr = wid >> 2, wc = wid & 3, fr = lane & 15, fq = lane >> 4;
    int R0, C0; stage_rc(tid * 16, R0, C0);
    const int RB = Epi::PERM ? ((R0 & ~31) + perm32(R0 & 31)) : R0;
    const unsigned CB = (unsigned)C0 * 2u;
    const unsigned ldsw = (unsigned)wid * 1024u;
    const int aoff = lds_byte(wr * 64 + fr, fq * 8), boff = lds_byte(wc * 32 + fr, fq * 8);
#define PG8_SA(b, h) (((b) * 2 + (h)) * HTB)
#define PG8_SB(b, h) ((4 + (b) * 2 + (h)) * HTB)
#define PG8_STAGE(bufoff, gbase, off, q) do { \
        __builtin_amdgcn_global_load_lds((const unsigned*)((const char*)(gbase) + (off)), (LAS unsigned*)(lds + (bufoff) + ldsw), 16, 0, 0); \
        __builtin_amdgcn_global_load_lds((const unsigned*)((const char*)(gbase) + (q) + (off)), (LAS unsigned*)(lds + (bufoff) + ldsw + 8192), 16, 0, 0); } while (0)
#define PG8_LDA(dst, b, h) do { _Pragma("unroll") for (int m = 0; m < 4; ++m) _Pragma("unroll") for (int k = 0; k < 2; ++k) dst[m][k] = *(const LAS bf16x8*)(lds + PG8_SA(b, h) + aoff + m * 2048 + k * 1024); } while (0)
#define PG8_LDB(dst, b, h) do { _Pragma("unroll") for (int n = 0; n < 2; ++n) _Pragma("unroll") for (int k = 0; k < 2; ++k) dst[n][k] = *(const LAS bf16x8*)(lds + PG8_SB(b, h) + boff + n * 2048 + k * 1024); } while (0)
#define PG8_MMA(ai, bj, At, Bt) do { __builtin_amdgcn_s_setprio(1); _Pragma("unroll") for (int m = 0; m < 4; ++m) _Pragma("unroll") for (int n = 0; n < 2; ++n) _Pragma("unroll") for (int k = 0; k < 2; ++k) \
        acc[ai][bj][m][n] = __builtin_amdgcn_mfma_f32_16x16x32_bf16(Bt[n][k], At[m][k], acc[ai][bj][m][n], 0, 0, 0); __builtin_amdgcn_s_setprio(0); } while (0)
#define PG8_WAIT_V(n) asm volatile("s_waitcnt vmcnt(" #n ")" ::: "memory")
#define PG8_WAIT_L(n) asm volatile("s_waitcnt lgkmcnt(" #n ")" ::: "memory")
#define PG8_BAR __builtin_amdgcn_s_barrier()
#define PG8_SCHED __builtin_amdgcn_sched_barrier(0)
    Unit cur, nxt; int ui = 0;
    if (!S.next(0, cur)) return;
    f32x4 acc[2][2][4][2];
#pragma unroll
    for (int a = 0; a < 2; ++a)
#pragma unroll
        for (int b = 0; b < 2; ++b)
#pragma unroll
            for (int m = 0; m < 4; ++m)
#pragma unroll
                for (int n = 0; n < 2; ++n) acc[a][b][m][n] = (f32x4){0.f, 0.f, 0.f, 0.f};
    bf16x8 At[4][2], B0[2][2], B1[2][2];
    const char* cA = cur.A; const char* cB = cur.B;
    unsigned offA = (unsigned)R0 * (unsigned)cur.lda + CB, offB = (unsigned)RB * (unsigned)cur.ldb + CB;
    int qA = 64 * cur.lda, qB = 64 * cur.ldb;
    int hA = 128 * cur.lda, hB = 128 * cur.ldb;
    constexpr int kstep = BK * 2;
    PG8_STAGE(PG8_SB(0, 0), cB, offB, qB); PG8_STAGE(PG8_SB(0, 1), cB + hB, offB, qB); PG8_STAGE(PG8_SA(0, 0), cA, offA, qA); PG8_STAGE(PG8_SA(0, 1), cA + hA, offA, qA);
    if (wr == 1) PG8_BAR;
    PG8_WAIT_V(2); PG8_BAR;
    PG8_STAGE(PG8_SB(1, 0), cB + kstep, offB, qB); PG8_STAGE(PG8_SA(1, 0), cA + kstep, offA, qA); PG8_STAGE(PG8_SB(1, 1), cB + hB + kstep, offB, qB);
    PG8_WAIT_V(6); PG8_BAR;
    for (;;) {
        const bool has_next = S.next(ui + 1, nxt);
        const char* nA = has_next ? nxt.A : cA; const char* nB = has_next ? nxt.B : cB;
        const int nlda = has_next ? nxt.lda : cur.lda, nldb = has_next ? nxt.ldb : cur.ldb;
        unsigned noffA, noffB;
        { int t3 = tid; asm volatile("" : "+v"(t3));
          int R0n, C0n; stage_rc(t3 * 16, R0n, C0n); const int RBn = Epi::PERM ? ((R0n & ~31) + perm32(R0n & 31)) : R0n;
          noffA = (unsigned)R0n * (unsigned)nlda + (unsigned)C0n * 2u; noffB = (unsigned)RBn * (unsigned)nldb + (unsigned)C0n * 2u; }
        const int nqA = 64 * nlda, nqB = 64 * nldb, nhA = 128 * nlda, nhB = 128 * nldb;
        const int nt = cur.nt;
        for (int t = 0; t < nt; t += 2) {
            const bool last = (t == nt - 2);
            const char* a1 = cA + (size_t)(t + 1) * kstep;
            const char* a2 = last ? nA : cA + (size_t)(t + 2) * kstep; const char* b2 = last ? nB : cB + (size_t)(t + 2) * kstep;
            const char* a3 = a2 + kstep; const char* b3 = b2 + kstep;
            const unsigned oA2 = last ? noffA : offA, oB2 = last ? noffB : offB;
            const int qA2 = last ? nqA : qA, qB2 = last ? nqB : qB, hA2 = last ? nhA : hA, hB2 = last ? nhB : hB;
            PG8_LDB(B0, 0, 0); PG8_LDB(B1, 0, 1); PG8_SCHED; PG8_LDA(At, 0, 0); PG8_STAGE(PG8_SA(1, 1), a1 + hA, offA, qA);
            PG8_WAIT_V(8); PG8_WAIT_L(0); PG8_BAR; PG8_MMA(0, 0, At, B0); PG8_MMA(0, 1, At, B1); PG8_BAR; PG8_SCHED;
            PG8_LDA(At, 0, 1); PG8_STAGE(PG8_SB(0, 0), b2, oB2, qB2); PG8_STAGE(PG8_SB(0, 1), b2 + hB2, oB2, qB2); PG8_STAGE(PG8_SA(0, 0), a2, oA2, qA2);
            PG8_WAIT_V(8); PG8_WAIT_L(0); PG8_BAR; PG8_MMA(1, 0, At, B0); PG8_MMA(1, 1, At, B1); PG8_BAR; PG8_SCHED;
            PG8_LDB(B0, 1, 0); PG8_LDB(B1, 1, 1); PG8_SCHED; PG8_LDA(At, 1, 0); PG8_STAGE(PG8_SA(0, 1), a2 + hA2, oA2, qA2);
            PG8_WAIT_V(8); PG8_WAIT_L(0); PG8_BAR; PG8_MMA(0, 0, At, B0); PG8_MMA(0, 1, At, B1); PG8_BAR; PG8_SCHED;
            PG8_LDA(At, 1, 1); PG8_STAGE(PG8_SB(1, 0), b3, oB2, qB2); PG8_STAGE(PG8_SB(1, 1), b3 + hB2, oB2, qB2); PG8_STAGE(PG8_SA(1, 0), a3, oA2, qA2);
            PG8_WAIT_V(8); PG8_WAIT_L(0); PG8_BAR; PG8_MMA(1, 0, At, B0); PG8_MMA(1, 1, At, B1); PG8_BAR; PG8_SCHED;
        }
        if (wr == 0) PG8_BAR;
        { int t4 = tid; asm volatile("" : "+v"(t4));
          E(acc, cur, t4, wr, wc, t4 & 15, (t4 & 63) >> 4); }
        if (!has_next) break;
#pragma unroll
        for (int a = 0; a < 2; ++a)
#pragma unroll
            for (int b = 0; b < 2; ++b)
#pragma unroll
                for (int m = 0; m < 4; ++m)
#pragma unroll
                    for (int n = 0; n < 2; ++n) acc[a][b][m][n] = (f32x4){0.f, 0.f, 0.f, 0.f};
        cur = nxt; cA = nA; cB = nB; offA = noffA; offB = noffB; qA = nqA; qB = nqB; hA = nhA; hB = nhB; ++ui;
        if (wr == 1) PG8_BAR;
    }
    PG8_WAIT_V(0);
    PG8_BAR;
#undef PG8_SA
#undef PG8_SB
#undef PG8_STAGE
#undef PG8_LDA
#undef PG8_LDB
#undef PG8_MMA
#undef PG8_WAIT_V
#undef PG8_WAIT_L
#undef PG8_BAR
#undef PG8_SCHED
}
}

struct USched {
    int kind;
    pg8::StaticOrder o; const char* A; const char* B; int lda, ldb, nt;
    const char* Wg; const char* Wbr;
    const char* PB;
    __device__ __forceinline__ bool next(int i, pg8::Unit& u) const {
        if (kind == 0) {
            int pm, pn; if (!o.next(i, pm, pn)) return false;
            u.A = A + (size_t)pm * 256 * lda; u.B = B + (size_t)pn * 256 * ldb; u.lda = lda; u.ldb = ldb; u.nt = nt; u.pm = pm; u.pn = pn; u.sub = 0; return true;
        } else if (kind == 1) {
            const int L = i * o.G + o.c; if (L >= 160) return false;
            const int l = L / 40, r = L % 40, pm = r >> 2, pn = r & 3;
            u.A = A + ((size_t)l * 2560 + pm * 256) * 2048; u.B = B + ((size_t)l * WL + OFF_KV) * 2 + (size_t)pn * 256 * 2048;
            u.lda = 2048; u.ldb = 2048; u.nt = 16; u.pm = l * 10 + pm; u.pn = pn; u.sub = 0; return true;
        } else {
            const int tile = i / 6, s = i - tile * 6, br = s >> 1;
            int pm, pn; if (!o.next(tile, pm, pn)) return false;
            u.pm = pm; u.pn = pn; u.sub = s;
            if (!(s & 1)) { u.A = A + (size_t)pm * 256 * 2048; u.lda = 2048; u.B = Wg + ((size_t)br * 1024 + pn * 256) * 2048; u.ldb = 2048; u.nt = 16; }
            else { const int co = br == 0 ? 0 : (br == 1 ? 2048 : 2560);
                   u.A = PB + (size_t)pm * 256 * (PC * 2) + co * 2; u.lda = PC * 2; u.B = Wbr + (size_t)br * (1024 * 512 * 2) + (size_t)pn * 256 * 1024; u.ldb = 1024; u.nt = 8; }
            return true;
        }
    }
};
struct UEpi {
    static constexpr bool PERM = true;
    int kind;
    bf16_t* O; int ldc; const float* bgate; u32x4* park;
    int vt; bf16_t* VT;
    __device__ __forceinline__ void operator()(const f32x4 (&acc)[2][2][4][2], const pg8::Unit& u, int tid, int wr, int wc, int fr, int fq) const {
        const int row0 = u.pm * 256 + wr * 64 + fr;
        if (kind == 0 && ((vt == 1 && (u.pn == 4 || u.pn == 5)) || (vt == 2 && u.pn >= 2))) {
#pragma unroll
            for (int ai = 0; ai < 2; ++ai)
#pragma unroll
                for (int m = 0; m < 4; ++m) {
                    const int row = row0 + ai * 128 + m * 16;
                    size_t rbase; int dstride;
                    if (vt == 1) { const int b = row >> 13, t = row & 8191, r = t >> 6, c = t & 63; rbase = ((size_t)(b * 8) * 128 + r) * 4096 + c; dstride = 64; }
                    else { const int l = row / 2560, rem = row - l * 2560, b = rem >> 8, key = rem & 255, kk = key & 31;
                           rbase = ((size_t)(l * 10 + b) * 4) * 32768 + (key >> 5) * 32 + 8 * ((kk & 15) >> 2) + 4 * (kk >> 4) + (kk & 3); dstride = 256; }
#pragma unroll
                    for (int bj = 0; bj < 2; ++bj) {
                        const int col = (vt == 1 ? (u.pn - 4) : (u.pn - 2)) * 256 + bj * 128 + wc * 32 + 8 * fq;
                        const int hh = vt == 1 ? (col >> 6) : (col >> 7), d = vt == 1 ? (col & 63) : (col & 127);
                        bf16_t* p = VT + rbase + (vt == 1 ? (size_t)hh * 128 * 4096 : (size_t)hh * 32768) + (size_t)d * dstride;
                        const f32x4 v0 = acc[ai][bj][m][0], v1 = acc[ai][bj][m][1];
                        const unsigned w0 = cvt_pk_bf16(v0[0], v0[1]), w1 = cvt_pk_bf16(v0[2], v0[3]), w2 = cvt_pk_bf16(v1[0], v1[1]), w3 = cvt_pk_bf16(v1[2], v1[3]);
                        p[0 * dstride] = (bf16_t)(w0 & 0xffffu); p[1 * dstride] = (bf16_t)(w0 >> 16); p[2 * dstride] = (bf16_t)(w1 & 0xffffu); p[3 * dstride] = (bf16_t)(w1 >> 16);
                        p[4 * dstride] = (bf16_t)(w2 & 0xffffu); p[5 * dstride] = (bf16_t)(w2 >> 16); p[6 * dstride] = (bf16_t)(w3 & 0xffffu); p[7 * dstride] = (bf16_t)(w3 >> 16);
                    }
                    if (m & 1) asm volatile("" ::: "memory");
                }
        } else if (kind == 0) {
            const int col0 = u.pn * 256 + wc * 32 + 8 * fq;
#pragma unroll
            for (int ai = 0; ai < 2; ++ai)
#pragma unroll
                for (int m = 0; m < 4; ++m) { bf16_t* rowp = O + (size_t)(row0 + ai * 128 + m * 16) * ldc + col0;
#pragma unroll
                    for (int bj = 0; bj < 2; ++bj) { const f32x4 v0 = acc[ai][bj][m][0], v1 = acc[ai][bj][m][1];
                        u32x4 w; w.x = cvt_pk_bf16(v0[0], v0[1]); w.y = cvt_pk_bf16(v0[2], v0[3]); w.z = cvt_pk_bf16(v1[0], v1[1]); w.w = cvt_pk_bf16(v1[2], v1[3]);
                        *(u32x4*)(rowp + bj * 128) = w; } }
        } else if (kind == 1) {
            const int col0 = u.pn * 128 + wc * 32 + 8 * fq;
#pragma unroll
            for (int ai = 0; ai < 2; ++ai)
#pragma unroll
                for (int m = 0; m < 4; ++m) {
                    float r[8];
#pragma unroll
                    for (int n = 0; n < 2; ++n)
#pragma unroll
                        for (int e = 0; e < 4; ++e) { const float av = acc[ai][0][m][n][e], bv = acc[ai][1][m][n][e]; r[n * 4 + e] = av * sigmoidf_(av) * bv; }
                    u32x4 w; w.x = cvt_pk_bf16(r[0], r[1]); w.y = cvt_pk_bf16(r[2], r[3]); w.z = cvt_pk_bf16(r[4], r[5]); w.w = cvt_pk_bf16(r[6], r[7]);
                    *(u32x4*)(O + (size_t)(row0 + ai * 128 + m * 16) * DFF + col0) = w; }
        } else {
            const int br = u.sub >> 1; const bool isg = !(u.sub & 1);
            const int col0 = u.pn * 256 + wc * 32 + 8 * fq;
            u32x4* pk = park + tid; asm volatile("" : "+v"(pk));
#pragma unroll
            for (int bj = 0; bj < 2; ++bj) {
                f32x4 b0 = (f32x4){0.f, 0.f, 0.f, 0.f}, b1 = b0;
                if (isg) { const float* bp = bgate + br * 1024 + col0 + bj * 128; b0 = *(const f32x4*)bp * -1.4426950408889634f; b1 = *(const f32x4*)(bp + 4) * -1.4426950408889634f; }
#pragma unroll
                for (int ai = 0; ai < 2; ++ai)
#pragma unroll
                    for (int m = 0; m < 4; ++m) {
                        const f32x4 v0 = acc[ai][bj][m][0], v1 = acc[ai][bj][m][1];
                        u32x4* slot = pk + ((ai * 4 + m) * 2 + bj) * 512;
                        if (isg) {
#define SG2(v, bb) __builtin_amdgcn_rcpf(1.0f + __builtin_amdgcn_exp2f(__builtin_fmaf((v), -1.4426950408889634f, (bb))))
                            u32x4 w; w.x = cvt_pk_bf16(SG2(v0[0], b0[0]), SG2(v0[1], b0[1])); w.y = cvt_pk_bf16(SG2(v0[2], b0[2]), SG2(v0[3], b0[3]));
                            w.z = cvt_pk_bf16(SG2(v1[0], b1[0]), SG2(v1[1], b1[1])); w.w = cvt_pk_bf16(SG2(v1[2], b1[2]), SG2(v1[3], b1[3]));
#undef SG2
                            *slot = w;
                        } else {
                            const u32x4 g = *slot;
                            bf16_t* op = O + (size_t)(row0 + ai * 128 + m * 16) * ldc + col0 + bj * 128;
                            float r[8];
                            r[0] = bflo(g.x) * v0[0]; r[1] = bfhi(g.x) * v0[1]; r[2] = bflo(g.y) * v0[2]; r[3] = bfhi(g.y) * v0[3];
                            r[4] = bflo(g.z) * v1[0]; r[5] = bfhi(g.z) * v1[1]; r[6] = bflo(g.w) * v1[2]; r[7] = bfhi(g.w) * v1[3];
                            if (br > 0) { const u32x4 o = *(const u32x4*)op;
                                r[0] += bflo(o.x); r[1] += bfhi(o.x); r[2] += bflo(o.y); r[3] += bfhi(o.y); r[4] += bflo(o.z); r[5] += bfhi(o.z); r[6] += bflo(o.w); r[7] += bfhi(o.w); }
                            u32x4 w; w.x = cvt_pk_bf16(r[0], r[1]); w.y = cvt_pk_bf16(r[2], r[3]); w.z = cvt_pk_bf16(r[4], r[5]); w.w = cvt_pk_bf16(r[6], r[7]);
                            *(u32x4*)op = w;
                        }
                        if (m & 1) asm volatile("" ::: "memory");
                    }
            }
        }
    }
};

struct Args { const float* in[31]; float* out; unsigned char* ws; int ph_lo, ph_hi; };
struct Ctx {
    LAS unsigned long long* tab; int tid;
    __device__ __forceinline__ unsigned long long rd(int k) const { const unsigned long long v = tab[k];
        const unsigned lo = __builtin_amdgcn_readfirstlane((unsigned)v), hi = __builtin_amdgcn_readfirstlane((unsigned)(v >> 32)); return ((unsigned long long)hi << 32) | lo; }
    __device__ __forceinline__ const float* in(int k) const { return (const float*)(const __attribute__((address_space(1))) float*)rd(k); }
    __device__ __forceinline__ float* out() const { return (float*)(__attribute__((address_space(1))) float*)rd(31); }
    __device__ __forceinline__ unsigned char* ws() const { return (unsigned char*)(__attribute__((address_space(1))) unsigned char*)rd(32); }
};

__device__ __forceinline__ void tr_item(const float* W, int K, int N, bf16_t* WT, int item, LAS float* scr, int lane, bool upmap) {
    const int nblk = N / 32, kb = item / nblk, nb = item % nblk, k0 = 64 * kb, n0 = 32 * nb;
#pragma unroll 8
    for (int i = 0; i < 32; ++i) { const int kk = 2 * i + (lane >> 5); scr[kk * 33 + (lane & 31)] = W[(size_t)(k0 + kk) * N + n0 + (lane & 31)]; }
    asm volatile("s_waitcnt lgkmcnt(0)" ::: "memory");
    int row0 = n0;
    if (upmap) { if (n0 < DFF) row0 = 256 * (n0 / 128) + (n0 % 128); else { const int c2 = n0 - DFF; row0 = 256 * (c2 / 128) + 128 + (c2 % 128); } }
    const int c = lane & 7;
#pragma unroll
    for (int j = 0; j < 4; ++j) { const int n = (lane >> 3) + 8 * j; const LAS float* s = scr + (8 * c) * 33 + n;
        u32x4 o; o.x = cvt_pk_bf16(s[0 * 33], s[1 * 33]); o.y = cvt_pk_bf16(s[2 * 33], s[3 * 33]); o.z = cvt_pk_bf16(s[4 * 33], s[5 * 33]); o.w = cvt_pk_bf16(s[6 * 33], s[7 * 33]);
        *(u32x4*)(WT + (size_t)(row0 + n) * K + k0 + 8 * c) = o; }
    asm volatile("s_waitcnt lgkmcnt(0)" ::: "memory");
}

__device__ __forceinline__ void p0_prologue(const Ctx& a, LAS unsigned char* lds) {
    const int tid = a.tid, lane = tid & 63, wave = tid >> 6;
    const int gw = blockIdx.x * 8 + wave, NGW = gridDim.x * 8;
    LAS float* scr = (LAS float*)(lds + wave * 16384);
    bf16_t* Wb = (bf16_t*)(a.ws() + WS_W);
    constexpr int I_UP = 16 * 176, I_DN = 44 * 32, I_IN = 16 * 96, I_BR = 8 * 32, I_SQ = 16 * 32, I_LRU = 64;
    constexpr int ITEMS_L = 2 * I_UP + 2 * I_DN + 2 * I_IN + 3 * I_BR + 2 * I_SQ + I_LRU;
    for (int it = gw; it < NL * ITEMS_L; it += NGW) {
        const int l = it / ITEMS_L; int r = it - l * ITEMS_L;
        bf16_t* WLb = Wb + (size_t)l * WL;
        if (r < I_UP) { tr_item(a.in(5) + (size_t)l * 1024 * 5632, 1024, 5632, WLb + OFF_UP1, r, scr, lane, true); continue; } r -= I_UP;
        if (r < I_DN) { tr_item(a.in(6) + (size_t)l * DFF * 1024, DFF, 1024, WLb + OFF_DN1, r, scr, lane, false); continue; } r -= I_DN;
        if (r < I_UP) { tr_item(a.in(28) + (size_t)l * 1024 * 5632, 1024, 5632, WLb + OFF_UP2, r, scr, lane, true); continue; } r -= I_UP;
        if (r < I_DN) { tr_item(a.in(29) + (size_t)l * DFF * 1024, DFF, 1024, WLb + OFF_DN2, r, scr, lane, false); continue; } r -= I_DN;
        if (r < I_IN) { tr_item(a.in(9) + (size_t)l * 1024 * 3072, 1024, 3072, WLb + OFF_IN, r, scr, lane, false); continue; } r -= I_IN;
        if (r < I_IN) { tr_item(a.in(20) + (size_t)l * 1024 * 3072, 1024, 3072, WLb + OFF_GATE, r, scr, lane, false); continue; } r -= I_IN;
        if (r < I_BR) { tr_item(a.in(22) + (size_t)l * 512 * 1024, 512, 1024, WLb + OFF_BR, r, scr, lane, false); continue; } r -= I_BR;
        if (r < I_BR) { tr_item(a.in(23) + (size_t)l * 512 * 1024, 512, 1024, WLb + OFF_BR + 1024 * 512, r, scr, lane, false); continue; } r -= I_BR;
        if (r < I_BR) { tr_item(a.in(24) + (size_t)l * 512 * 1024, 512, 1024, WLb + OFF_BR + 2 * 1024 * 512, r, scr, lane, false); continue; } r -= I_BR;
        if (r < I_SQ) { tr_item(a.in(25) + (size_t)l * 1024 * 1024, 1024, 1024, WLb + OFF_OUT, r, scr, lane, false); continue; } r -= I_SQ;
        if (r < I_SQ) { tr_item(a.in(19) + (size_t)l * 1024 * 1024, 1024, 1024, WLb + OFF_KV, r, scr, lane, false); continue; } r -= I_SQ;
        { const int half = r & 1, n = (r >> 1) & 7, mat = (r >> 4) & 1, dir = r >> 5;
          const float* src = (mat ? a.in(15) : a.in(13)) + ((size_t)(l * 2 + dir) * 8 + n) * 4096;
          tr_item(src, 64, 64, WLb + OFF_LRU + ((size_t)(dir * 2 + mat) * 8 + n) * 4096, half, scr, lane, false); }
    }
    bf16_t* memN = (bf16_t*)(a.ws() + WS_B);
    for (int row = gw; row < 2560; row += NGW) {
        const float* src = row < 2048 ? a.in(2) + (size_t)row * 1024 : a.in(3) + (size_t)(row - 2048) * 1024;
        f32x4 v[4]; float ss = 0.f;
#pragma unroll
        for (int j = 0; j < 4; ++j) { v[j] = *(const f32x4*)(src + 4 * lane + 256 * j); ss += v[j][0] * v[j][0] + v[j][1] * v[j][1] + v[j][2] * v[j][2] + v[j][3] * v[j][3]; }
        const float rs = rsqrtf(wave_sum(ss) * (1.f / 1024.f) + EPS);
        for (int l = 0; l < NL; ++l) {
#pragma unroll
            for (int j = 0; j < 4; ++j) { const f32x4 g = *(const f32x4*)(a.in(18) + l * 1024 + 4 * lane + 256 * j);
                u32x2 w; w.x = cvt_pk_bf16(v[j][0] * rs * g[0], v[j][1] * rs * g[1]); w.y = cvt_pk_bf16(v[j][2] * rs * g[2], v[j][3] * rs * g[3]);
                *(u32x2*)(memN + ((size_t)l * 2560 + row) * 1024 + 4 * lane + 256 * j) = w; }
        }
    }
    bf16_t* HA = (bf16_t*)(a.ws() + WS_A);
    for (int row = gw; row < T; row += NGW) {
        const float* src = row < 65536 ? a.in(0) + (size_t)row * 1024 : a.in(1) + (size_t)(row - 65536) * 1024;
        f32x4 v[4]; float ss = 0.f;
#pragma unroll
        for (int j = 0; j < 4; ++j) { v[j] = *(const f32x4*)(src + 4 * lane + 256 * j); ss += v[j][0] * v[j][0] + v[j][1] * v[j][1] + v[j][2] * v[j][2] + v[j][3] * v[j][3]; }
        const float rs = rsqrtf(wave_sum(ss) * (1.f / 1024.f) + EPS);
#pragma unroll
        for (int j = 0; j < 4; ++j) { const f32x4 g = *(const f32x4*)(a.in(4) + 4 * lane + 256 * j);
            *(f32x4*)(a.out() + (size_t)row * 1024 + 4 * lane + 256 * j) = v[j];
            u32x2 w; w.x = cvt_pk_bf16(v[j][0] * rs * g[0], v[j][1] * rs * g[1]); w.y = cvt_pk_bf16(v[j][2] * rs * g[2], v[j][3] * rs * g[3]);
            *(u32x2*)(HA + (size_t)row * 1024 + 4 * lane + 256 * j) = w; }
    }
}

__device__ __forceinline__ void e_phase(const Ctx& a, float* X, bf16_t* FA, const float* gpost, float scale, const float* gpre) {
    const int tid = a.tid, lane = tid & 63, wave = tid >> 6;
    const int gw = blockIdx.x * 8 + wave, NGW = gridDim.x * 8;
    u32x2 fn[4]; f32x4 xn[4];
    f32x4 gp[4], gq[4];
#pragma unroll
    for (int j = 0; j < 4; ++j) { gp[j] = *(const f32x4*)(gpost + 4 * lane + 256 * j); gq[j] = gpre ? *(const f32x4*)(gpre + 4 * lane + 256 * j) : (f32x4){0.f, 0.f, 0.f, 0.f}; }
    if (gw < T) {
#pragma unroll
        for (int j = 0; j < 4; ++j) { fn[j] = *(const u32x2*)(FA + (size_t)gw * 1024 + 4 * lane + 256 * j); xn[j] = __builtin_nontemporal_load((const f32x4*)(X + (size_t)gw * 1024 + 4 * lane + 256 * j)); }
    }
    for (int row = gw; row < T; row += NGW) {
        float* xr = X + (size_t)row * 1024; bf16_t* fr = FA + (size_t)row * 1024;
        f32x4 f[4], x[4]; float ss = 0.f;
#pragma unroll
        for (int j = 0; j < 4; ++j) { f[j] = (f32x4){bflo(fn[j].x), bfhi(fn[j].x), bflo(fn[j].y), bfhi(fn[j].y)}; x[j] = xn[j];
            ss += f[j][0] * f[j][0] + f[j][1] * f[j][1] + f[j][2] * f[j][2] + f[j][3] * f[j][3]; }
        const int nrow = row + NGW;
        if (nrow < T) {
#pragma unroll
            for (int j = 0; j < 4; ++j) { fn[j] = *(const u32x2*)(FA + (size_t)nrow * 1024 + 4 * lane + 256 * j); xn[j] = __builtin_nontemporal_load((const f32x4*)(X + (size_t)nrow * 1024 + 4 * lane + 256 * j)); }
        }
        const float rs = rsqrtf(wave_sum(ss) * (1.f / 1024.f) + EPS) * scale;
        float s2 = 0.f;
#pragma unroll
        for (int j = 0; j < 4; ++j) { const f32x4 g = gp[j];
            x[j] = x[j] + f[j] * g * rs; __builtin_nontemporal_store(x[j], (f32x4*)(xr + 4 * lane + 256 * j));
            s2 += x[j][0] * x[j][0] + x[j][1] * x[j][1] + x[j][2] * x[j][2] + x[j][3] * x[j][3]; }
        if (gpre) {
            const float r2 = rsqrtf(wave_sum(s2) * (1.f / 1024.f) + EPS);
#pragma unroll
            for (int j = 0; j < 4; ++j) { const f32x4 g = gq[j];
                u32x2 w; w.x = cvt_pk_bf16(x[j][0] * r2 * g[0], x[j][1] * r2 * g[1]); w.y = cvt_pk_bf16(x[j][2] * r2 * g[2], x[j][3] * r2 * g[3]);
                *(u32x2*)(fr + 4 * lane + 256 * j) = w; }
        }
    }
}

template <bool NA>
__device__ __forceinline__ void attn_wave(bf16_t* PB, const bf16_t* KV, const float* rpb_h, int b, int hh, int r, int j, int qt, const bf16_t* VT, int lane, LAS float* RP) {
    constexpr int D = NA ? 64 : 128, NDC = D / 32, NDT = D / 16;
    const int c15 = lane & 15, g = lane >> 4;
    int rs = 0, bs = 0; size_t qtok; bf16_t* qp;
    if (NA) { qtok = (size_t)b * SEQ + r * 64 + 16 * j + c15; qp = PB + qtok * PC + hh * 64; rs = min(max(r - 4, 0), 120); bs = min(max(16 * j - 8, 0), 32); }
    else { qtok = (size_t)b * SEQ + qt * 16 + c15; qp = PB + qtok * PC + 2560 + hh * 128; }
    bf16x8 qf[NDC];
#pragma unroll
    for (int dc = 0; dc < NDC; ++dc) qf[dc] = *(const bf16x8*)(qp + 32 * dc + 8 * g);
    if (NA) {
#pragma unroll
        for (int i = 0; i < 8; ++i) { const int idx = lane + 64 * i; if (idx < 465) RP[idx] = rpb_h[idx]; }
        __builtin_amdgcn_wave_barrier();
    }
    f32x4 S[16];
#pragma unroll
    for (int kt = 0; kt < 16; ++kt) {
        const bf16_t* kp;
        if (NA) { const size_t ktok = (size_t)b * SEQ + (rs + (kt >> 1)) * 64 + bs + 16 * (kt & 1) + c15; kp = PB + ktok * PC + 512 + hh * 64; }
        else kp = KV + (size_t)(b * 256 + 16 * kt + c15) * 1024 + hh * 128;
        f32x4 acc = (f32x4){0.f, 0.f, 0.f, 0.f};
#pragma unroll
        for (int dc = 0; dc < NDC; ++dc) { const bf16x8 kf = *(const bf16x8*)(kp + 32 * dc + 8 * g); acc = __builtin_amdgcn_mfma_f32_16x16x32_bf16(kf, qf[dc], acc, 0, 0, 0); }
        S[kt] = acc;
    }
    const float scale = NA ? 0.125f : 0.08838834764831845f;
    float mx = -3.0e38f;
#pragma unroll
    for (int kt = 0; kt < 16; ++kt)
#pragma unroll
        for (int jj = 0; jj < 4; ++jj) {
            float s = S[kt][jj] * scale;
            if (NA) {
                const int kc = bs + 16 * (kt & 1) + 4 * g + jj, qc = 16 * j + c15, wsq = min(max(qc - 8, 0), 48);
                const bool valid = (kc >= wsq) && (kc < wsq + 16);
                const int dci = min(max(kc - qc, -15), 15) + 15, dri = rs + (kt >> 1) - r + 7;
                s = valid ? s + RP[dri * 31 + dci] : -1.0e30f;
            }
            S[kt][jj] = s; mx = fmaxf(mx, s);
        }
    mx = fmaxf(mx, __shfl_xor(mx, 16)); mx = fmaxf(mx, __shfl_xor(mx, 32));
    float sum = 0.f;
#pragma unroll
    for (int kt = 0; kt < 16; ++kt)
#pragma unroll
        for (int jj = 0; jj < 4; ++jj) { const float p = __expf(S[kt][jj] - mx); S[kt][jj] = p; sum += p; }
    sum += __shfl_xor(sum, 16); sum += __shfl_xor(sum, 32);
    const float inv = 1.0f / sum;
    f32x4 O[NDT];
#pragma unroll
    for (int dt = 0; dt < NDT; ++dt) O[dt] = (f32x4){0.f, 0.f, 0.f, 0.f};
#pragma unroll
    for (int kc8 = 0; kc8 < 8; ++kc8) {
        u32x4 pw; pw.x = cvt_pk_bf16(S[2 * kc8][0], S[2 * kc8][1]); pw.y = cvt_pk_bf16(S[2 * kc8][2], S[2 * kc8][3]);
        pw.z = cvt_pk_bf16(S[2 * kc8 + 1][0], S[2 * kc8 + 1][1]); pw.w = cvt_pk_bf16(S[2 * kc8 + 1][2], S[2 * kc8 + 1][3]);
        const bf16x8 pb = __builtin_bit_cast(bf16x8, pw);
#pragma unroll
        for (int dt = 0; dt < NDT; ++dt) {
            bf16x8 vf;
            if (NA) { const bf16_t* vp = VT + ((((size_t)(b * 8 + hh) * 128 + (rs + kc8)) * 64 + 16 * dt + c15) * 64) + bs + 4 * g;
                      const u32x2 p0 = *(const u32x2*)vp, p1 = *(const u32x2*)(vp + 16); u32x4 t; t.x = p0.x; t.y = p0.y; t.z = p1.x; t.w = p1.y; vf = __builtin_bit_cast(bf16x8, t); }
            else vf = *(const bf16x8*)(VT + (((size_t)(b * 4 + hh) * 128 + 16 * dt + c15) * 256) + 32 * kc8 + 8 * g);
            O[dt] = __builtin_amdgcn_mfma_f32_16x16x32_bf16(vf, pb, O[dt], 0, 0, 0);
        }
    }
#pragma unroll
    for (int dt = 0; dt < NDT; ++dt) { u32x2 w; w.x = cvt_pk_bf16(O[dt][0] * inv, O[dt][1] * inv); w.y = cvt_pk_bf16(O[dt][2] * inv, O[dt][3] * inv);
        *(u32x2*)(qp + 16 * dt + 4 * g) = w; }
}

constexpr int L_XC = 0, L_WA = 34816, L_HB = 38912, L_WL = 104448, L_CW = 122880, L_RP = 124416;
__device__ __forceinline__ void na_block(bf16_t* PB, const bf16_t* VT, const float* rpb_h, int b, int hh, int rp, LAS unsigned char* lds, int tid, bool fill_rp, u32x4 (&kpre)[9], bf16x8 (&qpre)[2], bool have, int nx) {
    const bool has_next = nx < 5120; const int nb = nx >> 9, nhh = nx & 7, nrp = (nx >> 3) & 63;
    const int lane = tid & 63, w = tid >> 6, c15 = lane & 15, g = lane >> 4;
    const int r = 2 * rp + (w >> 2), j = w & 3;
    const int rsU = min(max(2 * rp - 4, 0), 120), rs = min(max(r - 4, 0), 120), ro = rs - rsU, bs = min(max(16 * j - 8, 0), 32);
    LAS unsigned char* KS = lds;
    LAS float* RP = (LAS float*)(lds + L_RP + w * 2048);
    __syncthreads();
    if (!have) {
        { unsigned off = ((unsigned)(b * SEQ + rsU * 64 + (tid >> 3)) * (unsigned)PC + (unsigned)(512 + hh * 64 + 8 * (tid & 7))) * 2u;
#pragma unroll
          for (int i = 0; i < 9; ++i) { kpre[i] = (rsU + i) < 128 ? *(const u32x4*)((const char*)PB + off) : (u32x4){0u, 0u, 0u, 0u}; off += 64u * PC * 2u; } }
    }
#pragma unroll
    for (int i = 0; i < 9; ++i) { const int v = tid + 512 * i; *(LAS u32x4*)(KS + (v >> 3) * 144 + (v & 7) * 16) = kpre[i]; }
    if (fill_rp) {
#pragma unroll
        for (int i = 0; i < 8; ++i) { const int idx = lane + 64 * i; if (idx < 465) RP[idx] = 1.4426950408889634f * rpb_h[idx]; }
    }
    bf16_t* qp = PB + ((size_t)b * SEQ + r * 64 + 16 * j + c15) * PC + hh * 64;
    bf16x8 qf[2];
    if (!have) {
#pragma unroll
        for (int dc = 0; dc < 2; ++dc) qpre[dc] = *(const bf16x8*)(qp + 32 * dc + 8 * g);
    }
#pragma unroll
    for (int dc = 0; dc < 2; ++dc) qf[dc] = qpre[dc];
    __syncthreads();
    f32x4 S[16];
#pragma unroll
    for (int kt = 0; kt < 16; ++kt) {
        const int key = (ro + (kt >> 1)) * 64 + bs + 16 * (kt & 1) + c15;
        f32x4 acc = (f32x4){0.f, 0.f, 0.f, 0.f};
#pragma unroll
        for (int dc = 0; dc < 2; ++dc) { const bf16x8 kf = *(const LAS bf16x8*)(KS + key * 144 + (32 * dc + 8 * g) * 2); acc = __builtin_amdgcn_mfma_f32_16x16x32_bf16(kf, qf[dc], acc, 0, 0, 0); }
        S[kt] = acc;
        if ((kt & 3) == 3) asm volatile("" ::: "memory");
    }
    u32x4 vv[9];
    { unsigned off = ((unsigned)((((b * 8 + hh) * 128 + rsU) * 64 + (tid >> 3)) * 64) + (unsigned)(8 * (tid & 7))) * 2u;
#pragma unroll
      for (int i = 0; i < 9; ++i) { vv[i] = (rsU + i) < 128 ? *(const u32x4*)((const char*)VT + off) : (u32x4){0u, 0u, 0u, 0u}; off += 64u * 64u * 2u; } }
    float mx = -3.0e38f;
#pragma unroll
    for (int kt = 0; kt < 16; ++kt)
#pragma unroll
        for (int jj = 0; jj < 4; ++jj) {
            const int kc = bs + 16 * (kt & 1) + 4 * g + jj, qc = 16 * j + c15, wsq = min(max(qc - 8, 0), 48);
            const bool valid = (kc >= wsq) && (kc < wsq + 16);
            const int dci = min(max(kc - qc, -15), 15) + 15, dri = rs + (kt >> 1) - r + 7;
            const float sv = valid ? __builtin_fmaf(S[kt][jj], 0.125f * 1.4426950408889634f, RP[dri * 31 + dci]) : -1.0e30f;
            S[kt][jj] = sv; mx = fmaxf(mx, sv);
        }
    mx = fmaxf(mx, __shfl_xor(mx, 16)); mx = fmaxf(mx, __shfl_xor(mx, 32));
    float sum = 0.f;
#pragma unroll
    for (int kt = 0; kt < 16; ++kt)
#pragma unroll
        for (int jj = 0; jj < 4; ++jj) { const float p = __builtin_amdgcn_exp2f(S[kt][jj] - mx); S[kt][jj] = p; sum += p; }
    sum += __shfl_xor(sum, 16); sum += __shfl_xor(sum, 32);
    const float inv = 1.0f / sum;
    __syncthreads();
#pragma unroll
    for (int i = 0; i < 9; ++i) { const int v = tid + 512 * i; *(LAS u32x4*)(KS + (v >> 3) * 144 + (v & 7) * 16) = vv[i]; }
    if (has_next) {
        const int nrsU = min(max(2 * nrp - 4, 0), 120);
        { unsigned off = ((unsigned)(nb * SEQ + nrsU * 64 + (tid >> 3)) * (unsigned)PC + (unsigned)(512 + nhh * 64 + 8 * (tid & 7))) * 2u;
#pragma unroll
          for (int i = 0; i < 9; ++i) { kpre[i] = (nrsU + i) < 128 ? *(const u32x4*)((const char*)PB + off) : (u32x4){0u, 0u, 0u, 0u}; off += 64u * PC * 2u; } }
        const bf16_t* nqp = PB + ((size_t)nb * SEQ + (2 * nrp + (w >> 2)) * 64 + 16 * j + c15) * PC + nhh * 64;
#pragma unroll
        for (int dc = 0; dc < 2; ++dc) qpre[dc] = *(const bf16x8*)(nqp + 32 * dc + 8 * g);
    }
    __syncthreads();
    f32x4 O[4];
#pragma unroll
    for (int dt = 0; dt < 4; ++dt) O[dt] = (f32x4){0.f, 0.f, 0.f, 0.f};
#pragma unroll
    for (int kc8 = 0; kc8 < 8; ++kc8) {
        u32x4 pw; pw.x = cvt_pk_bf16(S[2 * kc8][0], S[2 * kc8][1]); pw.y = cvt_pk_bf16(S[2 * kc8][2], S[2 * kc8][3]);
        pw.z = cvt_pk_bf16(S[2 * kc8 + 1][0], S[2 * kc8 + 1][1]); pw.w = cvt_pk_bf16(S[2 * kc8 + 1][2], S[2 * kc8 + 1][3]);
        const bf16x8 pb = __builtin_bit_cast(bf16x8, pw);
#pragma unroll
        for (int dt = 0; dt < 4; ++dt) {
            const LAS unsigned char* vp = KS + ((ro + kc8) * 64 + 16 * dt + c15) * 144 + (bs + 4 * g) * 2;
            const u32x2 p0 = *(const LAS u32x2*)vp, p1 = *(const LAS u32x2*)(vp + 32);
            u32x4 t; t.x = p0.x; t.y = p0.y; t.z = p1.x; t.w = p1.y;
            O[dt] = __builtin_amdgcn_mfma_f32_16x16x32_bf16(__builtin_bit_cast(bf16x8, t), pb, O[dt], 0, 0, 0);
        }
        if (kc8 & 1) asm volatile("" ::: "memory");
    }
#pragma unroll
    for (int dt = 0; dt < 4; ++dt) { u32x2 wv; wv.x = cvt_pk_bf16(O[dt][0] * inv, O[dt][1] * inv); wv.y = cvt_pk_bf16(O[dt][2] * inv, O[dt][3] * inv);
        *(u32x2*)(qp + 16 * dt + 4 * g) = wv; }
}

__device__ __forceinline__ void ca_block(bf16_t* PB, const bf16_t* KV, const bf16_t* VT, int b, int hh, int q256, LAS unsigned char* lds, int tid, u32x4 (&pk)[8], u32x4 (&pv)[8], bool have, int nx) {
    const int lane = tid & 63, w = tid >> 6, c15 = lane & 15, g = lane >> 4;
    LAS unsigned char* Ks = lds;
    LAS unsigned char* Vs = lds + 69632;
    if (!have) {
#pragma unroll
        for (int i = 0; i < 8; ++i) { const int v = tid + 512 * i, row = v >> 4, c16 = v & 15; pk[i] = *(const u32x4*)(KV + (size_t)(b * 256 + row) * 1024 + hh * 128 + 8 * c16); }
#pragma unroll
        for (int i = 0; i < 8; ++i) { const int v = tid + 512 * i, drow = v >> 5, c32 = v & 31; pv[i] = *(const u32x4*)(VT + ((size_t)(b * 4 + hh) * 128 + drow) * 256 + 8 * c32); }
    }
    __syncthreads();
#pragma unroll
    for (int i = 0; i < 8; ++i) { const int v = tid + 512 * i; *(LAS u32x4*)(Ks + (v >> 4) * 272 + (v & 15) * 16) = pk[i]; }
#pragma unroll
    for (int i = 0; i < 8; ++i) { const int v = tid + 512 * i; *(LAS u32x4*)(Vs + (v >> 5) * 528 + (v & 31) * 16) = pv[i]; }
    __syncthreads();
    if (nx < 1280) {
        const int nhh = nx & 3, nb = nx >> 7;
#pragma unroll
        for (int i = 0; i < 8; ++i) { const int v = tid + 512 * i, row = v >> 4, c16 = v & 15; pk[i] = *(const u32x4*)(KV + (size_t)(nb * 256 + row) * 1024 + nhh * 128 + 8 * c16); }
#pragma unroll
        for (int i = 0; i < 8; ++i) { const int v = tid + 512 * i, drow = v >> 5, c32 = v & 31; pv[i] = *(const u32x4*)(VT + ((size_t)(nb * 4 + nhh) * 128 + drow) * 256 + 8 * c32); }
    }
#pragma unroll 1
    for (int round = 0; round < 2; ++round) {
        const int qt = q256 * 16 + round * 8 + w;
        bf16_t* qp = PB + ((size_t)b * SEQ + qt * 16 + c15) * PC + 2560 + hh * 128;
        bf16x8 qf[4];
#pragma unroll
        for (int dc = 0; dc < 4; ++dc) qf[dc] = *(const bf16x8*)(qp + 32 * dc + 8 * g);
        f32x4 S[16];
#pragma unroll
        for (int kt = 0; kt < 16; ++kt) {
            f32x4 acc = (f32x4){0.f, 0.f, 0.f, 0.f};
#pragma unroll
            for (int dc = 0; dc < 4; ++dc) { const bf16x8 kf = *(const LAS bf16x8*)(Ks + (16 * kt + c15) * 272 + (32 * dc + 8 * g) * 2); acc = __builtin_amdgcn_mfma_f32_16x16x32_bf16(kf, qf[dc], acc, 0, 0, 0); }
            S[kt] = acc;
            if (kt & 1) asm volatile("" ::: "memory");
        }
        float mx = -3.0e38f;
#pragma unroll
        for (int kt = 0; kt < 16; ++kt)
#pragma unroll
            for (int jj = 0; jj < 4; ++jj) { const float sv = S[kt][jj] * (0.08838834764831845f * 1.4426950408889634f); S[kt][jj] = sv; mx = fmaxf(mx, sv); }
        mx = fmaxf(mx, __shfl_xor(mx, 16)); mx = fmaxf(mx, __shfl_xor(mx, 32));
        float sum = 0.f;
#pragma unroll
        for (int kt = 0; kt < 16; ++kt)
#pragma unroll
            for (int jj = 0; jj < 4; ++jj) { const float p = __builtin_amdgcn_exp2f(S[kt][jj] - mx); S[kt][jj] = p; sum += p; }
        sum += __shfl_xor(sum, 16); sum += __shfl_xor(sum, 32);
        const float inv = 1.0f / sum;
        f32x4 O[8];
#pragma unroll
        for (int dt = 0; dt < 8; ++dt) O[dt] = (f32x4){0.f, 0.f, 0.f, 0.f};
#pragma unroll
        for (int kc8 = 0; kc8 < 8; ++kc8) {
            u32x4 pw; pw.x = cvt_pk_bf16(S[2 * kc8][0], S[2 * kc8][1]); pw.y = cvt_pk_bf16(S[2 * kc8][2], S[2 * kc8][3]);
            pw.z = cvt_pk_bf16(S[2 * kc8 + 1][0], S[2 * kc8 + 1][1]); pw.w = cvt_pk_bf16(S[2 * kc8 + 1][2], S[2 * kc8 + 1][3]);
            const bf16x8 pb = __builtin_bit_cast(bf16x8, pw);
#pragma unroll
            for (int dt = 0; dt < 8; ++dt) { const bf16x8 vf = *(const LAS bf16x8*)(Vs + (16 * dt + c15) * 528 + (32 * kc8 + 8 * g) * 2); O[dt] = __builtin_amdgcn_mfma_f32_16x16x32_bf16(vf, pb, O[dt], 0, 0, 0); }
            asm volatile("" ::: "memory");
        }
#pragma unroll
        for (int dt = 0; dt < 8; ++dt) { u32x2 wv; wv.x = cvt_pk_bf16(O[dt][0] * inv, O[dt][1] * inv); wv.y = cvt_pk_bf16(O[dt][2] * inv, O[dt][3] * inv);
            *(u32x2*)(qp + 16 * dt + 4 * g) = wv; }
    }
}

constexpr int LSEG = 512, NSEG = SEQ / LSEG;
__device__ __forceinline__ void lru_item(const Ctx& a, LAS unsigned char* lds, int l, int b, int n, int seg, int pass, const int tid) {
    const int lane = tid & 63, w = tid >> 6, c15 = lane & 15, g = lane >> 4;
    unsigned char* ws = a.ws();
    bf16_t* PB = (bf16_t*)(ws + WS_B); float* AGG = (float*)(ws + WS_AGG);
    const bf16_t* LW = (const bf16_t*)(ws + WS_W) + (size_t)l * WL + OFF_LRU;
    const int cb = 64 * n; const size_t tok0 = (size_t)b * SEQ;
    LAS float* XC = (LAS float*)(lds + L_XC);
    LAS float* WA = (LAS float*)(lds + L_WA);
    LAS bf16_t* HB = (LAS bf16_t*)(lds + L_HB);
    LAS unsigned char* WLs = lds + L_WL;
    LAS float* CWs = (LAS float*)(lds + L_CW);
    LAS float* AGs = (LAS float*)(lds + L_RP);
    const float* cw = a.in(11) + (size_t)l * 4 * 512 + cb; const float* cbias = a.in(12) + (size_t)l * 512 + cb;
    const int cg8 = tid & 7;
    u32x4 wpre[2]; f32x4 agpre = (f32x4){0.f, 0.f, 0.f, 0.f};
    LAS float* CPs = (LAS float*)(lds + 133120);
    u32x4 xr[2][4];
    auto load_consts = [&](int d) {
        const bf16_t* Wsrc = LW + ((size_t)(d * 2) * 8 + n) * 4096;
#pragma unroll
        for (int i = 0; i < 2; ++i) { const int v = tid + 512 * i, mat = v >> 9, row = (v >> 3) & 63, c8 = v & 7; wpre[i] = *(const u32x4*)(Wsrc + (size_t)mat * 8 * 4096 + row * 64 + 8 * c8); }
        if (pass == 1) agpre = *(const f32x4*)(AGG + ((size_t)((b * 8 + n) * 2 + d) * NSEG) * 128 + 4 * tid);
    };
    auto load_x = [&](int dir, int c) {
        const int tl0n = dir ? LSEG - 128 * (c + 1) : 128 * c; const int t0n = seg * LSEG + tl0n;
        const bool interior = (t0n >= 2) && (t0n + 130 <= SEQ);
#pragma unroll
        for (int rep = 0; rep < 2; ++rep) { const int tokl = (tid + 512 * rep) >> 3;
            const int ts0 = t0n + tokl - 2;
            unsigned off = ((unsigned)((int)tok0 + ts0) * (unsigned)PC + (unsigned)(1536 + cb + 8 * cg8)) * 2u;
            if (interior) {
#pragma unroll
                for (int tap = 0; tap < 4; ++tap) { xr[rep][tap] = *(const u32x4*)((const char*)PB + off); off += PC * 2; }
            } else {
#pragma unroll
                for (int tap = 0; tap < 4; ++tap) { const int ts = ts0 + tap;
                    xr[rep][tap] = (ts >= 0 && ts < SEQ) ? *(const u32x4*)((const char*)PB + off) : (u32x4){0u, 0u, 0u, 0u}; off += PC * 2; }
            } }
    };
    load_consts(1); load_x(1, 0);
    if (tid < 320) CWs[tid] = tid < 256 ? cw[(tid >> 6) * 512 + (tid & 63)] : cbias[tid - 256];
    if (tid >= 384) { const int d = (tid - 384) >> 6, chl = tid & 63, ch = (l * 2 + d) * 512 + cb + chl;
        const float lam = a.in(17)[ch];
        CPs[d * 192 + chl] = -1.4426950408889634f * a.in(14)[ch]; CPs[d * 192 + 64 + chl] = -1.4426950408889634f * a.in(16)[ch];
        CPs[d * 192 + 128 + chl] = -8.0f * 1.4426950408889634f * ((lam > 15.f) ? __expf(-lam) : log1pf(__expf(-lam))); }
#pragma unroll
    for (int sweep = 0; sweep < 2; ++sweep) {
        const int dir = 1 - sweep;
#pragma unroll
        for (int i = 0; i < 2; ++i) { const int v = tid + 512 * i, mat = v >> 9, row = (v >> 3) & 63, c8 = v & 7; *(LAS u32x4*)(WLs + mat * 9216 + row * 144 + c8 * 16) = wpre[i]; }
        if (pass == 1) *(LAS f32x4*)(AGs + 4 * tid) = agpre;
        float ba[4], bi[4], sp[4], hin[4], ain[4];
#pragma unroll
        for (int nt = 0; nt < 4; ++nt) { hin[nt] = 0.f; ain[nt] = 1.f; }
        __syncthreads();
#pragma unroll
        for (int nt = 0; nt < 4; ++nt) { ba[nt] = CPs[dir * 192 + 16 * nt + c15]; bi[nt] = CPs[dir * 192 + 64 + 16 * nt + c15]; sp[nt] = CPs[dir * 192 + 128 + 16 * nt + c15]; }
        if (pass == 1) {
#pragma unroll
            for (int nt = 0; nt < 4; ++nt) { float h0 = 0.f;
                if (dir == 0) { for (int s2 = 0; s2 < seg; ++s2) { const LAS float* q = AGs + s2 * 128 + (16 * nt + c15) * 2; h0 = q[0] * h0 + q[1]; } }
                else { for (int s2 = NSEG - 1; s2 > seg; --s2) { const LAS float* q = AGs + s2 * 128 + (16 * nt + c15) * 2; h0 = q[0] * h0 + q[1]; } }
                hin[nt] = h0; }
        }
        for (int c = 0; c < LSEG / 128; ++c) {
            const int tl0 = dir ? LSEG - 128 * (c + 1) : 128 * c;
#pragma unroll
            for (int rep = 0; rep < 2; ++rep) {
                const int tokl = (tid + 512 * rep) >> 3, i = dir ? 127 - tokl : tokl;
                f32x4 o0 = *(const LAS f32x4*)(CWs + 256 + 8 * cg8), o1 = *(const LAS f32x4*)(CWs + 256 + 8 * cg8 + 4);
#pragma unroll
                for (int tap = 0; tap < 4; ++tap) {
                    const u32x4 xv = xr[rep][tap];
                    const f32x4 w0 = *(const LAS f32x4*)(CWs + tap * 64 + 8 * cg8), w1 = *(const LAS f32x4*)(CWs + tap * 64 + 8 * cg8 + 4);
                    o0[0] += bflo(xv.x) * w0[0]; o0[1] += bfhi(xv.x) * w0[1]; o0[2] += bflo(xv.y) * w0[2]; o0[3] += bfhi(xv.y) * w0[3];
                    o1[0] += bflo(xv.z) * w1[0]; o1[1] += bfhi(xv.z) * w1[1]; o1[2] += bflo(xv.w) * w1[2]; o1[3] += bfhi(xv.w) * w1[3];
                }
                *(LAS f32x4*)(XC + i * 68 + 8 * cg8) = o0;
                *(LAS f32x4*)(XC + i * 68 + 8 * cg8 + 4) = o1;
            }
            if (c + 1 < LSEG / 128) load_x(dir, c + 1);
            bf16_t gq[4][4];
            const unsigned gbase = ((unsigned)((int)tok0 + seg * LSEG + tl0 + 16 * w + 4 * g) * (unsigned)PC + (unsigned)(2048 + cb + c15)) * 2u;
            if (pass == 1 && sweep == 1) {
#pragma unroll
                for (int nt = 0; nt < 4; ++nt)
#pragma unroll
                    for (int jj = 0; jj < 4; ++jj) gq[nt][jj] = *(const bf16_t*)((const char*)PB + gbase + (unsigned)(jj * PC * 2 + nt * 32));
            }
            __syncthreads();
            bf16x8 Af[2];
#pragma unroll
            for (int kc = 0; kc < 2; ++kc) { const f32x4 x0 = *(const LAS f32x4*)(XC + (16 * w + c15) * 68 + 32 * kc + 8 * g), x1 = *(const LAS f32x4*)(XC + (16 * w + c15) * 68 + 32 * kc + 8 * g + 4);
                u32x4 pw; pw.x = cvt_pk_bf16(x0[0], x0[1]); pw.y = cvt_pk_bf16(x0[2], x0[3]); pw.z = cvt_pk_bf16(x1[0], x1[1]); pw.w = cvt_pk_bf16(x1[2], x1[3]); Af[kc] = __builtin_bit_cast(bf16x8, pw); }
            float hl[4][4], pc[4][4], eA[4], eH[4];
#pragma unroll
            for (int nt = 0; nt < 4; ++nt) {
                f32x4 pr = (f32x4){0.f, 0.f, 0.f, 0.f}, pi = pr;
#pragma unroll
                for (int kc = 0; kc < 2; ++kc) {
                    const bf16x8 wa8 = *(const LAS bf16x8*)(WLs + (16 * nt + c15) * 144 + (32 * kc + 8 * g) * 2), wi8 = *(const LAS bf16x8*)(WLs + 9216 + (16 * nt + c15) * 144 + (32 * kc + 8 * g) * 2);
                    pr = __builtin_amdgcn_mfma_f32_16x16x32_bf16(Af[kc], wa8, pr, 0, 0, 0); pi = __builtin_amdgcn_mfma_f32_16x16x32_bf16(Af[kc], wi8, pi, 0, 0, 0); }
                float hp = 0.f, pp = 1.f;
#pragma unroll
                for (int jj = 0; jj < 4; ++jj) {
                    const float rg = __builtin_amdgcn_rcpf(1.0f + __builtin_amdgcn_exp2f(__builtin_fmaf(pr[jj], -1.4426950408889634f, ba[nt])));
                    const float ig = __builtin_amdgcn_rcpf(1.0f + __builtin_amdgcn_exp2f(__builtin_fmaf(pi[jj], -1.4426950408889634f, bi[nt])));
                    const float av = __builtin_amdgcn_exp2f(rg * sp[nt]); const float mu = __builtin_amdgcn_sqrtf(fmaxf(__builtin_fmaf(-av, av, 1.0f), 0.f));
                    const float xv = XC[(16 * w + 4 * g + jj) * 68 + 16 * nt + c15];
                    const float uv = mu * ig * xv;
                    hp = av * hp + uv; pp = av * pp; hl[nt][jj] = hp; pc[nt][jj] = pp;
                }
                float iA = pp, iH = hp;
                float tA = __shfl_up(iA, 16), tH = __shfl_up(iH, 16); if (g >= 1) { iH = iA * tH + iH; iA = iA * tA; }
                tA = __shfl_up(iA, 32); tH = __shfl_up(iH, 32); if (g >= 2) { iH = iA * tH + iH; iA = iA * tA; }
                float xA = __shfl_up(iA, 16), xH = __shfl_up(iH, 16); if (g == 0) { xA = 1.f; xH = 0.f; }
                eA[nt] = xA; eH[nt] = xH;
                if (g == 3) { WA[(w * 64 + 16 * nt + c15) * 2] = iA; WA[(w * 64 + 16 * nt + c15) * 2 + 1] = iH; }
            }
            if (c + 1 == LSEG / 128 && sweep == 0) { load_consts(0); load_x(0, 0); }
            __syncthreads();
#pragma unroll
            for (int nt = 0; nt < 4; ++nt) {
                float cwv = hin[nt], cin = 0.f, ap = ain[nt];
#pragma unroll
                for (int w2 = 0; w2 < 8; ++w2) { const float A2 = WA[(w2 * 64 + 16 * nt + c15) * 2], H2 = WA[(w2 * 64 + 16 * nt + c15) * 2 + 1]; if (w2 == w) cin = cwv; cwv = A2 * cwv + H2; ap *= A2; }
                hin[nt] = cwv; ain[nt] = ap;
                if (pass == 1) {
                    const float cl = eA[nt] * cin + eH[nt];
#pragma unroll
                    for (int jj = 0; jj < 4; ++jj) {
                        const float hv = pc[nt][jj] * cl + hl[nt][jj];
                        const int i = 16 * w + 4 * g + jj, tl = tl0 + (dir ? 127 - i : i); const int ch = 16 * nt + c15;
                        if (sweep == 0) { HB[tl * 64 + ch] = (bf16_t)(cvt_pk_bf16(hv, 0.f) & 0xffffu); }
                        else { const float hb = bf2f(HB[tl * 64 + ch]); const float gl = bf2f(gq[nt][jj]);
                               *(bf16_t*)((char*)PB + gbase + (unsigned)(jj * PC * 2 + nt * 32)) = (bf16_t)(cvt_pk_bf16((hv + hb) * gelu_tanh(gl), 0.f) & 0xffffu); }
                    }
                }
            }
        }
        if (pass == 0 && w == 0 && g == 0) {
            float* q = AGG + ((size_t)((b * 8 + n) * 2 + dir) * NSEG + seg) * 128;
#pragma unroll
            for (int nt = 0; nt < 4; ++nt) { __hip_atomic_store(q + (16 * nt + c15) * 2, ain[nt], __ATOMIC_RELAXED, __HIP_MEMORY_SCOPE_AGENT); __hip_atomic_store(q + (16 * nt + c15) * 2 + 1, hin[nt], __ATOMIC_RELAXED, __HIP_MEMORY_SCOPE_AGENT); }
        }
        __syncthreads();
    }
}

__device__ __forceinline__ void mixer_phase(const Ctx& a, LAS unsigned char* lds, int l, int pass) {
    const int tid = a.tid;
    bf16_t* PB = (bf16_t*)(a.ws() + WS_B);
    const bf16_t* KV = (const bf16_t*)(a.ws() + WS_KVB) + (size_t)l * 2560 * 1024;
    constexpr int N_LRU = 80 * NSEG, N_NA = 5120, N_CA = 1280;
    const int G = (int)gridDim.x;
    for (int it = blockIdx.x; it < N_LRU; it += G) {
        int t2 = tid; asm volatile("" : "+v"(t2));
#ifndef SKIP_LRU
        lru_item(a, lds, l, it / (8 * NSEG), (it / NSEG) & 7, it % NSEG, pass, t2);
        __syncthreads();
#endif
    }
    if (pass == 0) {
        { int x0 = ((int)blockIdx.x - N_LRU) % G; if (x0 < 0) x0 += G;
          u32x4 kpre[9]; bf16x8 qpre[2];
          for (int x = x0; x < N_NA; x += G) {
              int t2 = tid; asm volatile("" : "+v"(t2));
              const int hh = x & 7, rp = (x >> 3) & 63, b = x >> 9;
#ifndef SKIP_NA
              na_block(PB, (const bf16_t*)(a.ws() + WS_S), a.in(10) + (size_t)(l * 8 + hh) * 465, b, hh, rp, lds, t2, (x == x0) || (gridDim.x & 7u), kpre, qpre, x != x0, x + G);
#endif
          } }
        { int x0 = ((int)blockIdx.x - N_LRU - N_NA) % G; if (x0 < 0) x0 += G;
          u32x4 pk[8], pv[8];
          for (int x = x0; x < N_CA; x += G) {
              int t2 = tid; asm volatile("" : "+v"(t2));
              const int hh = x & 3, q256 = (x >> 2) & 31, b = x >> 7;
#ifndef SKIP_CA
              ca_block(PB, KV, (const bf16_t*)(a.ws() + WS_VTC) + (size_t)l * 10 * 4 * 128 * 256, b, hh, q256, lds, t2, pk, pv, x != x0, x + G);
#endif
          } }
    }
    __syncthreads();
}

#define XB_TMO      128
#define XB_XCNT(j)  (256  + 64 * (j))
#define XB_XSUB(j)  (1280 + 64 * (j))
#define XB_XGEN(j)  (2304 + 64 * (j))
#define XB_TOP      3328
#define XB_TOPGEN   3392
#define XCD_BAR_WORDS 3456
#define XB_SPIN_CAP (1u << 22)
__device__ __forceinline__ unsigned xb_ld(unsigned* p)              { return __hip_atomic_load(p, __ATOMIC_RELAXED, __HIP_MEMORY_SCOPE_AGENT); }
__device__ __forceinline__ unsigned xb_add(unsigned* p, unsigned v) { return __hip_atomic_fetch_add(p, v, __ATOMIC_RELAXED, __HIP_MEMORY_SCOPE_AGENT); }
__device__ __forceinline__ unsigned xb_xcc_id() { return (unsigned)__builtin_amdgcn_s_getreg((3 << 11) | 20) & 0xFu; }
#define XB_SPIN(cond, bar) do { unsigned _sp = 0; while (cond) { __builtin_amdgcn_s_sleep(1); \
    if ((++_sp & 255u) == 0u) { if (xb_ld(&(bar)[XB_TMO])) break; if (_sp > XB_SPIN_CAP) { atomicAdd(&(bar)[XB_TMO], 1u); break; } } } } while (0)
struct XcdBarrier { unsigned* bar; unsigned x; volatile LAS unsigned* st; };
__device__ __forceinline__ XcdBarrier xcd_barrier_post(unsigned* bar, volatile LAS unsigned* st) {
    XcdBarrier b; b.bar = bar; b.x = xb_xcc_id(); b.st = st;
    if (threadIdx.x == 0) (void)xb_add(&bar[XB_XCNT(b.x)], 1u);
    return b;
}
__device__ __forceinline__ void xcd_barrier_complete(unsigned* bar, unsigned x, unsigned& nloc, unsigned& nx) {
    const unsigned G = gridDim.x * gridDim.y * gridDim.z;
    unsigned sum, cnt, mine, sp = 0u;
    for (;;) {
        sum = 0u; cnt = 0u; mine = 0u;
#pragma unroll
        for (unsigned j = 0; j < 16; ++j) { const unsigned c = xb_ld(&bar[XB_XCNT(j)]); sum += c; cnt += (c > 0u) ? 1u : 0u; mine = (j == x) ? c : mine; }
        if (sum == G) break;
        __builtin_amdgcn_s_sleep(1);
        if ((++sp & 255u) == 0u) { if (xb_ld(&bar[XB_TMO])) break; if (sp > XB_SPIN_CAP) { atomicAdd(&bar[XB_TMO], 1u); break; } }
    }
    nloc = mine > 0u ? mine : 1u; nx = cnt > 0u ? cnt : 1u;
}
__device__ __forceinline__ void xcd_barrier(const XcdBarrier& b) {
    asm volatile("s_waitcnt vmcnt(0)" ::: "memory");
    __syncthreads();
    if (threadIdx.x == 0) {
        unsigned* bar = b.bar;
        __builtin_amdgcn_s_waitcnt(0);
        unsigned nloc = b.st[0], nx = b.st[1];
        if (nloc == 0u) { xcd_barrier_complete(bar, b.x, nloc, nx); b.st[0] = nloc; b.st[1] = nx; }
        const unsigned old = xb_add(&bar[XB_XSUB(b.x)], 1u);
        const unsigned gen = old / nloc;
        if (old + 1u == (gen + 1u) * nloc) {
            __builtin_amdgcn_fence(__ATOMIC_RELEASE, "agent");
            asm volatile("s_waitcnt vmcnt(0)" ::: "memory");
            const unsigned og = xb_add(&bar[XB_TOP], 1u);
            const unsigned tg = og / nx;
            if (og + 1u == (tg + 1u) * nx) xb_add(&bar[XB_TOPGEN], 1u);
            else XB_SPIN(xb_ld(&bar[XB_TOPGEN]) == tg, bar);
            __builtin_amdgcn_fence(__ATOMIC_ACQUIRE, "agent");
            xb_add(&bar[XB_XGEN(b.x)], 1u);
            asm volatile("s_waitcnt vmcnt(0)" ::: "memory");
        } else {
            XB_SPIN(xb_ld(&bar[XB_XGEN(b.x)]) == gen, bar);
            __builtin_amdgcn_fence(__ATOMIC_ACQUIRE, "agent");
            asm volatile("s_waitcnt vmcnt(0)" ::: "memory");
        }
    }
    __syncthreads();
}

constexpr int NPL = 12, NPH = 2 + NPL * NL;
__global__ void __launch_bounds__(512, 2) mega(Args args) {
    extern __shared__ __attribute__((aligned(16))) unsigned char lds_raw[];
    LAS unsigned char* lds = (LAS unsigned char*)lds_raw;
    cg::grid_group grid = cg::this_grid();
    Ctx a; a.tab = (LAS unsigned long long*)(lds + 141000);
    { const unsigned long long* ka = (const unsigned long long*)__builtin_amdgcn_kernarg_segment_ptr();
      if (threadIdx.x < 33) a.tab[threadIdx.x] = ka[threadIdx.x];
      if (threadIdx.x == 64) { ((LAS unsigned*)(lds + 141500))[0] = 0u; ((LAS unsigned*)(lds + 141500))[1] = 0u; } }
    __syncthreads();
    XcdBarrier xbar = xcd_barrier_post((unsigned*)(args.ws + WS_CTL), (volatile LAS unsigned*)(lds + 141500));
    const int ph_lo = args.ph_lo, ph_hi = args.ph_hi;
    for (int ph = ph_lo; ph < ph_hi; ++ph) {
        if (ph > ph_lo) { if (ph == ph_lo + 1) grid.sync(); else xcd_barrier(xbar); }
        int tid = threadIdx.x; asm volatile("" : "+v"(tid));
        a.tid = tid;
        const int G = gridDim.x, c = blockIdx.x;
        unsigned char* ws = a.ws();
        const char* Wb = (const char*)(ws + WS_W);
        bf16_t* bufA = (bf16_t*)(ws + WS_A); bf16_t* bufB = (bf16_t*)(ws + WS_B);
        if (ph == 0) {
#ifndef SKIP_P0
            p0_prologue(a, lds);
#endif
            continue; }
        const int l = ph >= 2 ? (ph - 2) / NPL : 0, s = ph >= 2 ? (ph - 2) % NPL : -1;
        const char* WLc = Wb + (size_t)l * WL * 2;
        if (s == 2 || s == 8 || s == 11) {
            const float* gpost = a.in(s == 2 ? 7 : (s == 8 ? 26 : 30)) + l * 1024;
            const float* gpre = s == 2 ? a.in(8) + l * 1024 : (s == 8 ? a.in(27) + l * 1024 : (l + 1 < NL ? a.in(4) + (l + 1) * 1024 : nullptr));
#ifndef SKIP_E
            e_phase(a, a.out(), bufA, gpost, s == 8 ? 1.0f : 0.5f, gpre);
#endif
            continue;
        }
        if (s == 4 || s == 5) {
#ifndef SKIP_MIX
            mixer_phase(a, lds, l, s - 4);
#endif
            continue;
        }
        USched S; UEpi E;
        S.kind = 0; S.Wg = nullptr; S.Wbr = nullptr; S.PB = nullptr; E.kind = 0; E.bgate = nullptr; E.park = nullptr; E.O = bufA; E.ldc = 1024; E.vt = 0; E.VT = nullptr;
        S.A = (const char*)bufA; S.lda = 2048; S.B = WLc; S.ldb = 2048; S.nt = 16;
        if (ph == 1) { S.kind = 1; S.o.G = G; S.o.c = c; S.o.nM = 0; S.o.nN = 0; S.o.nwg = 0; S.A = (const char*)(ws + WS_B); S.B = Wb; E.O = (bf16_t*)(ws + WS_KVB); E.ldc = 1024; E.vt = 2; E.VT = (bf16_t*)(ws + WS_VTC); }
        else if (s == 0 || s == 9) { S.o.init(T, 5632, G, c); S.B = WLc + (s == 0 ? OFF_UP1 : OFF_UP2) * 2; E.kind = 1; E.O = bufB; E.ldc = DFF; }
        else if (s == 1 || s == 10) { S.o.init(T, 1024, G, c); S.A = (const char*)bufB; S.lda = DFF * 2; S.B = WLc + (s == 1 ? OFF_DN1 : OFF_DN2) * 2; S.ldb = DFF * 2; S.nt = 44; }
        else if (s == 3) { S.o.init(T, 3072, G, c); S.B = WLc + OFF_IN * 2; E.O = bufB; E.ldc = PC; E.vt = 1; E.VT = (bf16_t*)(ws + WS_S); }
        else if (s == 7) { S.o.init(T, 1024, G, c); S.A = (const char*)(bufB + 512); S.lda = PC * 2; S.B = WLc + OFF_OUT * 2; }
        else {
            S.kind = 2; S.o.init(T, 1024, G, c); S.PB = (const char*)bufB; S.Wg = WLc + OFF_GATE * 2; S.Wbr = WLc + OFF_BR * 2;
            E.kind = 2; E.O = bufB + 512; E.ldc = PC; E.bgate = a.in(21) + (size_t)l * 3072; E.park = (u32x4*)(ws + WS_S) + (size_t)c * 16 * 512;
        }
#ifndef SKIP_GEMM
        pg8::gemm_phase<UEpi, USched>(lds, tid, S, E);
#endif
    }
}

extern "C" void kernel_launch(void* const* d_in, const int* in_sizes, int n_in, void* d_out, int out_size, void* d_ws, size_t ws_size, hipStream_t stream) {
    static int grid = 0;
    if (grid == 0) {
        if (n_in != 31 || ws_size < WS_END || out_size != T * 1024) { fprintf(stderr, "kernel_launch: unexpected shapes (n_in %d, out %d, ws %zu)\n", n_in, out_size, ws_size); grid = -1; return; }
        int dev = 0, cus = 0, per_cu = 0;
        hipGetDevice(&dev); hipDeviceGetAttribute(&cus, hipDeviceAttributeMultiprocessorCount, dev);
        hipFuncSetAttribute((const void*)mega, hipFuncAttributeMaxDynamicSharedMemorySize, LDS_BYTES);
        hipOccupancyMaxActiveBlocksPerMultiprocessor(&per_cu, (const void*)mega, 512, LDS_BYTES);
        if (per_cu < 1) per_cu = 1;
        (void)hipGetLastError();
        grid = cus * per_cu;
    }
    if (grid < 0) return;
    hipMemsetAsync((char*)d_ws + WS_CTL, 0, 16384, stream);
    Args a{};
    for (int i = 0; i < 31; ++i) a.in[i] = (const float*)d_in[i];
    a.out = (float*)d_out; a.ws = (unsigned char*)d_ws;
#if MULTI_LAUNCH
    for (int ph = 0; ph < NPH; ++ph) { a.ph_lo = ph; a.ph_hi = ph + 1; hipLaunchKernelGGL(mega, dim3(grid), dim3(512), LDS_BYTES, stream, a); }
#else
    a.ph_lo = 0; a.ph_hi = NPH;
    void* args[] = {&a};
    hipError_t e = hipLaunchCooperativeKernel((const void*)mega, dim3(grid), dim3(512), args, LDS_BYTES, stream);
    if (e != hipSuccess) fprintf(stderr, "cooperative launch failed: %s (grid %d)\n", hipGetErrorString(e), grid);
#endif
}
```

```cpp
#include <hip/hip_runtime.h>
#include <hip/hip_cooperative_groups.h>
#include <cstdio>
#include <cstdint>
namespace cg = cooperative_groups;

#ifndef MULTI_LAUNCH
#define MULTI_LAUNCH 0
#endif

#define LAS __attribute__((address_space(3)))
typedef unsigned short bf16_t;
typedef short bf16x8 __attribute__((ext_vector_type(8)));
typedef float f32x4 __attribute__((ext_vector_type(4)));
typedef unsigned u32x4 __attribute__((ext_vector_type(4)));
typedef unsigned u32x2 __attribute__((ext_vector_type(2)));

constexpr int T = 81920, SEQ = 8192, NBAT = 10, NL = 4, DFF = 2816;
constexpr int PC = 3072;
constexpr float EPS = 1e-6f;

constexpr size_t WL = 27394048;
constexpr size_t OFF_UP1 = 0, OFF_DN1 = 5767168, OFF_UP2 = 8650752, OFF_DN2 = 14417920, OFF_IN = 17301504,
                 OFF_GATE = 20447232, OFF_BR = 23592960, OFF_OUT = 25165824, OFF_KV = 26214400, OFF_LRU = 27262976;
constexpr size_t WS_CTL = 0;
constexpr size_t WS_AGG = 65536;
constexpr size_t WS_W = 3u << 20;
constexpr size_t WS_KVB = WS_W + 4 * WL * 2;
constexpr size_t WS_A = WS_KVB + (size_t)4 * 2560 * 1024 * 2;
constexpr size_t WS_B = WS_A + (size_t)T * 1024 * 2;
constexpr size_t WS_S = WS_B + (size_t)T * 3072 * 2;
constexpr size_t WS_VTC = WS_S + (size_t)T * 512 * 2;
constexpr size_t WS_END = WS_VTC + (size_t)4 * 10 * 4 * 128 * 256 * 2;
static_assert(WS_END <= (size_t)1 << 30, "workspace");
constexpr int LDS_BYTES = 147456;

typedef float f32x2_t __attribute__((ext_vector_type(2)));
typedef __bf16 bf16x2_t __attribute__((ext_vector_type(2)));
__device__ __forceinline__ unsigned cvt_pk_bf16(float lo, float hi) { const f32x2_t v = {lo, hi}; const bf16x2_t b = __builtin_convertvector(v, bf16x2_t); return __builtin_bit_cast(unsigned, b); }
__device__ __forceinline__ float bflo(unsigned w) { return __uint_as_float(w << 16); }
__device__ __forceinline__ float bfhi(unsigned w) { return __uint_as_float(w & 0xffff0000u); }
__device__ __forceinline__ float bf2f(bf16_t v) { return __uint_as_float((unsigned)v << 16); }
__device__ __forceinline__ float sigmoidf_(float x) { return __builtin_amdgcn_rcpf(1.0f + __expf(-x)); }
__device__ __forceinline__ float wave_sum(float v) {
#pragma unroll
    for (int o = 1; o < 64; o <<= 1) v += __shfl_xor(v, o);
    return v;
}
__device__ __forceinline__ float gelu_tanh(float x) {
    const float t = __builtin_fmaf(x * x, 2.302208198f * 0.044715f, 2.302208198f);
    const float r = __builtin_amdgcn_rcpf(__builtin_amdgcn_exp2f(x * t) + 1.0f);
    return __builtin_fmaf(-x, r, x);
}

namespace pg8 {
constexpr int BM = 256, BK = 64, HALF = 128, HTB = HALF * BK * 2, STAGE_BYTES = 8 * HTB, NXCD = 8, WGM = 8;
__host__ __device__ __forceinline__ int lds_byte(int r, int c) { const int st = (r >> 4) * 2 + (c >> 5), rr = r & 15, cc = c & 31, ob = rr * 64 + cc * 2; return st * 1024 + (ob ^ (((ob >> 9) & 1) << 5)); }
__host__ __device__ __forceinline__ void stage_rc(int b, int& R, int& C) { const int st = b / 1024, sb = b % 1024, swz = sb ^ (((sb >> 9) & 1) << 5); R = (st >> 1) * 16 + swz / 64; C = (st & 1) * 32 + (swz % 64) / 2; }
__host__ __device__ __forceinline__ int perm32(int rho) { const int n = rho >> 4, i = rho & 15; return 8 * (i >> 2) + 4 * n + (i & 3); }

struct Unit { const char* A; const char* B; int lda, ldb, nt, pm, pn, sub; };

struct StaticOrder {
    int nM, nN, nwg, G, c;
    __device__ void init(int M, int N, int G_, int c_) { nM = M / BM; nN = N / BM; nwg = nM * nN; G = G_; c = c_; }
    __device__ bool next(int i, int& pm, int& pn) const {
        const long L = (long)i * G + c; if (__builtin_amdgcn_readfirstlane((int)(L >= nwg))) return false;
        int wgid = (int)L; { const int q = nwg / NXCD, r = nwg % NXCD, xcd = wgid % NXCD, off = wgid / NXCD; wgid = (xcd < r ? xcd * (q + 1) : r * (q + 1) + (xcd - r) * q) + off; }
        const int nig = WGM * nN, gid = wgid / nig, t = wgid - gid * nig, fm = gid * WGM, gsz = (nM - fm) < WGM ? (nM - fm) : WGM;
        int pm_, pn_;
        if (gsz == WGM) { pm_ = fm + (t & (WGM - 1)); pn_ = t >> 3; }
        else { pm_ = fm + t % gsz; pn_ = t / gsz; }
        pm = __builtin_amdgcn_readfirstlane(pm_); pn = __builtin_amdgcn_readfirstlane(pn_); return true;
    }
};

template <class Epi, class Sched>
__device__ __forceinline__ void gemm_phase(LAS unsigned char* lds, const int tid, const Sched& S, const Epi& E) {
    const int wid = __builtin_amdgcn_readfirstlane(tid >> 6), lane = tid & 63, wr = wid >> 2, wc = wid & 3, fr = lane & 15, fq = lane >> 4;
    int R0, C0; stage_rc(tid * 16, R0, C0);
    const int RB = Epi::PERM ? ((R0 & ~31) + perm32(R0 & 31)) : R0;
    const unsigned CB = (unsigned)C0 * 2u;
    const unsigned ldsw = (unsigned)wid * 1024u;
    const int aoff = lds_byte(wr * 64 + fr, fq * 8), boff = lds_byte(wc * 32 + fr, fq * 8);
#define PG8_SA(b, h) (((b) * 2 + (h)) * HTB)
#define PG8_SB(b, h) ((4 + (b) * 2 + (h)) * HTB)
#define PG8_STAGE(bufoff, gbase, off, q) do { \
        __builtin_amdgcn_global_load_lds((const unsigned*)((const char*)(gbase) + (off)), (LAS unsigned*)(lds + (bufoff) + ldsw), 16, 0, 0); \
        __builtin_amdgcn_global_load_lds((const unsigned*)((const char*)(gbase) + (q) + (off)), (LAS unsigned*)(lds + (bufoff) + ldsw + 8192), 16, 0, 0); } while (0)
#define PG8_LDA(dst, b, h) do { _Pragma("unroll") for (int m = 0; m < 4; ++m) _Pragma("unroll") for (int k = 0; k < 2; ++k) dst[m][k] = *(const LAS bf16x8*)(lds + PG8_SA(b, h) + aoff + m * 2048 + k * 1024); } while (0)
#define PG8_LDB(dst, b, h) do { _Pragma("unroll") for (int n = 0; n < 2; ++n) _Pragma("unroll") for (int k = 0; k < 2; ++k) dst[n][k] = *(const LAS bf16x8*)(lds + PG8_SB(b, h) + boff + n * 2048 + k * 1024); } while (0)
#define PG8_MMA(ai, bj, At, Bt) do { __builtin_amdgcn_s_setprio(1); _Pragma("unroll") for (int m = 0; m < 4; ++m) _Pragma("unroll") for (int n = 0; n < 2; ++n) _Pragma("unroll") for (int k = 0; k < 2; ++k) \
        acc[ai][bj][m][n] = __builtin_amdgcn_mfma_f32_16x16x32_bf16(Bt[n][k], At[m][k], acc[ai][bj][m][n], 0, 0, 0); __builtin_amdgcn_s_setprio(0); } while (0)
#define PG8_WAIT_V(n) asm volatile("s_waitcnt vmcnt(" #n ")" ::: "memory")
#define PG8_WAIT_L(n) asm volatile("s_waitcnt lgkmcnt(" #n ")" ::: "memory")
#define PG8_BAR __builtin_amdgcn_s_barrier()
#define PG8_SCHED __builtin_amdgcn_sched_barrier(0)
    Unit cur, nxt; int ui = 0;
    if (!S.next(0, cur)) return;
    f32x4 acc[2][2][4][2];
#pragma unroll
    for (int a = 0; a < 2; ++a)
#pragma unroll
        for (int b = 0; b < 2; ++b)
#pragma unroll
            for (int m = 0; m < 4; ++m)
#pragma unroll
                for (int n = 0; n < 2; ++n) acc[a][b][m][n] = (f32x4){0.f, 0.f, 0.f, 0.f};
    bf16x8 At[4][2], B0[2][2], B1[2][2];
    const char* cA = cur.A; const char* cB = cur.B;
    unsigned offA = (unsigned)R0 * (unsigned)cur.lda + CB, offB = (unsigned)RB * (unsigned)cur.ldb + CB;
    int qA = 64 * cur.lda, qB = 64 * cur.ldb;
    int hA = 128 * cur.lda, hB = 128 * cur.ldb;
    constexpr int kstep = BK * 2;
    PG8_STAGE(PG8_SB(0, 0), cB, offB, qB); PG8_STAGE(PG8_SB(0, 1), cB + hB, offB, qB); PG8_STAGE(PG8_SA(0, 0), cA, offA, qA); PG8_STAGE(PG8_SA(0, 1), cA + hA, offA, qA);
    if (wr == 1) PG8_BAR;
    PG8_WAIT_V(2); PG8_BAR;
    PG8_STAGE(PG8_SB(1, 0), cB + kstep, offB, qB); PG8_STAGE(PG8_SA(1, 0), cA + kstep, offA, qA); PG8_STAGE(PG8_SB(1, 1), cB + hB + kstep, offB, qB);
    PG8_WAIT_V(6); PG8_BAR;
    for (;;) {
        const bool has_next = S.next(ui + 1, nxt);
        const char* nA = has_next ? nxt.A : cA; const char* nB = has_next ? nxt.B : cB;
        const int nlda = has_next ? nxt.lda : cur.lda, nldb = has_next ? nxt.ldb : cur.ldb;
        unsigned noffA, noffB;
        { int t3 = tid; asm volatile("" : "+v"(t3));
          int R0n, C0n; stage_rc(t3 * 16, R0n, C0n); const int RBn = Epi::PERM ? ((R0n & ~31) + perm32(R0n & 31)) : R0n;
          noffA = (unsigned)R0n * (unsigned)nlda + (unsigned)C0n * 2u; noffB = (unsigned)RBn * (unsigned)nldb + (unsigned)C0n * 2u; }
        const int nqA = 64 * nlda, nqB = 64 * nldb, nhA = 128 * nlda, nhB = 128 * nldb;
        const int nt = cur.nt;
        for (int t = 0; t < nt; t += 2) {
            const bool last = (t == nt - 2);
            const char* a1 = cA + (size_t)(t + 1) * kstep;
            const char* a2 = last ? nA : cA + (size_t)(t + 2) * kstep; const char* b2 = last ? nB : cB + (size_t)(t + 2) * kstep;
            const char* a3 = a2 + kstep; const char* b3 = b2 + kstep;
            const unsigned oA2 = last ? noffA : offA, oB2 = last ? noffB : offB;
            const int qA2 = last ? nqA : qA, qB2 = last ? nqB : qB, hA2 = last ? nhA : hA, hB2 = last ? nhB : hB;
            PG8_LDB(B0, 0, 0); PG8_LDB(B1, 0, 1); PG8_SCHED; PG8_LDA(At, 0, 0); PG8_STAGE(PG8_SA(1, 1), a1 + hA, offA, qA);
            PG8_WAIT_V(8); PG8_WAIT_L(0); PG8_BAR; PG8_MMA(0, 0, At, B0); PG8_MMA(0, 1, At, B1); PG8_BAR; PG8_SCHED;
            PG8_LDA(At, 0, 1); PG8_STAGE(PG8_SB(0, 0), b2, oB2, qB2); PG8_STAGE(PG8_SB(0, 1), b2 + hB2, oB2, qB2); PG8_STAGE(PG8_SA(0, 0), a2, oA2, qA2);
            PG8_WAIT_V(8); PG8_WAIT_L(0); PG8_BAR; PG8_MMA(1, 0, At, B0); PG8_MMA(1, 1, At, B1); PG8_BAR; PG8_SCHED;
            PG8_LDB(B0, 1, 0); PG8_LDB(B1, 1, 1); PG8_SCHED; PG8_LDA(At, 1, 0); PG8_STAGE(PG8_SA(0, 1), a2 + hA2, oA2, qA2);
            PG8_WAIT_V(8); PG8_WAIT_L(0); PG8_BAR; PG8_MMA(0, 0, At, B0); PG8_MMA(0, 1, At, B1); PG8_BAR; PG8_SCHED;
            PG8_LDA(At, 1, 1); PG8_STAGE(PG8_SB(1, 0), b3, oB2, qB2); PG8_STAGE(PG8_SB(1, 1), b3 + hB2, oB2, qB2); PG8_STAGE(PG8_SA(1, 0), a3, oA2, qA2);
            PG8_WAIT_V(8); PG8_WAIT_L(0); PG8_BAR; PG8_MMA(1, 0, At, B0); PG8_MMA(1, 1, At, B1); PG8_BAR; PG8_SCHED;
        }
        if (wr == 0) PG8_BAR;
        { int t4 = tid; asm volatile("" : "+v"(t4));
          E(acc, cur, t4, wr, wc, t4 & 15, (t4 & 63) >> 4); }
        if (!has_next) break;
#pragma unroll
        for (int a = 0; a < 2; ++a)
#pragma unroll
            for (int b = 0; b < 2; ++b)
#pragma unroll
                for (int m = 0; m < 4; ++m)
#pragma unroll
                    for (int n = 0; n < 2; ++n) acc[a][b][m][n] = (f32x4){0.f, 0.f, 0.f, 0.f};
        cur = nxt; cA = nA; cB = nB; offA = noffA; offB = noffB; qA = nqA; qB = nqB; hA = nhA; hB = nhB; ++ui;
        if (wr == 1) PG8_BAR;
    }
    PG8_WAIT_V(0);
    PG8_BAR;
#undef PG8_SA
#undef PG8_SB
#undef PG8_STAGE
#undef PG8_LDA
#undef PG8_LDB
#undef PG8_MMA
#undef PG8_WAIT_V
#undef PG8_WAIT_L
#undef PG8_BAR
#undef PG8_SCHED
}
}

struct USched {
    int kind;
    pg8::StaticOrder o; const char* A; const char* B; int lda, ldb, nt;
    const char* Wg; const char* Wbr;
    const char* PB;
    __device__ __forceinline__ bool next(int i, pg8::Unit& u) const {
        if (kind == 0) {
            int pm, pn; if (!o.next(i, pm, pn)) return false;
            u.A = A + (size_t)pm * 256 * lda; u.B = B + (size_t)pn * 256 * ldb; u.lda = lda; u.ldb = ldb; u.nt = nt; u.pm = pm; u.pn = pn; u.sub = 0; return true;
        } else if (kind == 1) {
            const int L = i * o.G + o.c; if (L >= 160) return false;
            const int l = L / 40, r = L % 40, pm = r >> 2, pn = r & 3;
            u.A = A + ((size_t)l * 2560 + pm * 256) * 2048; u.B = B + ((size_t)l * WL + OFF_KV) * 2 + (size_t)pn * 256 * 2048;
            u.lda = 2048; u.ldb = 2048; u.nt = 16; u.pm = l * 10 + pm; u.pn = pn; u.sub = 0; return true;
        } else {
            const int tile = i / 6, s = i - tile * 6, br = s >> 1;
            int pm, pn; if (!o.next(tile, pm, pn)) return false;
            u.pm = pm; u.pn = pn; u.sub = s;
            if (!(s & 1)) { u.A = A + (size_t)pm * 256 * 2048; u.lda = 2048; u.B = Wg + ((size_t)br * 1024 + pn * 256) * 2048; u.ldb = 2048; u.nt = 16; }
            else { const int co = br == 0 ? 0 : (br == 1 ? 2048 : 2560);
                   u.A = PB + (size_t)pm * 256 * (PC * 2) + co * 2; u.lda = PC * 2; u.B = Wbr + (size_t)br * (1024 * 512 * 2) + (size_t)pn * 256 * 1024; u.ldb = 1024; u.nt = 8; }
            return true;
        }
    }
};
struct UEpi {
    static constexpr bool PERM = true;
    int kind;
    bf16_t* O; int ldc; const float* bgate; u32x4* park;
    int vt; bf16_t* VT;
    __device__ __forceinline__ void operator()(const f32x4 (&acc)[2][2][4][2], const pg8::Unit& u, int tid, int wr, int wc, int fr, int fq) const {
        const int row0 = u.pm * 256 + wr * 64 + fr;
        if (kind == 0 && ((vt == 1 && (u.pn == 4 || u.pn == 5)) || (vt == 2 && u.pn >= 2))) {
#pragma unroll
            for (int ai = 0; ai < 2; ++ai)
#pragma unroll
                for (int m = 0; m < 4; ++m) {
                    const int row = row0 + ai * 128 + m * 16;
                    size_t rbase; int dstride;
                    if (vt == 1) { const int b = row >> 13, t = row & 8191, r = t >> 6, c = t & 63; rbase = ((size_t)(b * 8) * 128 + r) * 4096 + c; dstride = 64; }
                    else { const int l = row / 2560, rem = row - l * 2560, b = rem >> 8, key = rem & 255, kk = key & 31;
                           rbase = ((size_t)(l * 10 + b) * 4) * 32768 + (key >> 5) * 32 + 8 * ((kk & 15) >> 2) + 4 * (kk >> 4) + (kk & 3); dstride = 256; }
#pragma unroll
                    for (int bj = 0; bj < 2; ++bj) {
                        const int col = (vt == 1 ? (u.pn - 4) : (u.pn - 2)) * 256 + bj * 128 + wc * 32 + 8 * fq;
                        const int hh = vt == 1 ? (col >> 6) : (col >> 7), d = vt == 1 ? (col & 63) : (col & 127);
                        bf16_t* p = VT + rbase + (vt == 1 ? (size_t)hh * 128 * 4096 : (size_t)hh * 32768) + (size_t)d * dstride;
                        const f32x4 v0 = acc[ai][bj][m][0], v1 = acc[ai][bj][m][1];
                        const unsigned w0 = cvt_pk_bf16(v0[0], v0[1]), w1 = cvt_pk_bf16(v0[2], v0[3]), w2 = cvt_pk_bf16(v1[0], v1[1]), w3 = cvt_pk_bf16(v1[2], v1[3]);
                        p[0 * dstride] = (bf16_t)(w0 & 0xffffu); p[1 * dstride] = (bf16_t)(w0 >> 16); p[2 * dstride] = (bf16_t)(w1 & 0xffffu); p[3 * dstride] = (bf16_t)(w1 >> 16);
                        p[4 * dstride] = (bf16_t)(w2 & 0xffffu); p[5 * dstride] = (bf16_t)(w2 >> 16); p[6 * dstride] = (bf16_t)(w3 & 0xffffu); p[7 * dstride] = (bf16_t)(w3 >> 16);
                    }
                    if (m & 1) asm volatile("" ::: "memory");
                }
        } else if (kind == 0) {
            const int col0 = u.pn * 256 + wc * 32 + 8 * fq;
#pragma unroll
            for (int ai = 0; ai < 2; ++ai)
#pragma unroll
                for (int m = 0; m < 4; ++m) { bf16_t* rowp = O + (size_t)(row0 + ai * 128 + m * 16) * ldc + col0;
#pragma unroll
                    for (int bj = 0; bj < 2; ++bj) { const f32x4 v0 = acc[ai][bj][m][0], v1 = acc[ai][bj][m][1];
                        u32x4 w; w.x = cvt_pk_bf16(v0[0], v0[1]); w.y = cvt_pk_bf16(v0[2], v0[3]); w.z = cvt_pk_bf16(v1[0], v1[1]); w.w = cvt_pk_bf16(v1[2], v1[3]);
                        *(u32x4*)(rowp + bj * 128) = w; } }
        } else if (kind == 1) {
            const int col0 = u.pn * 128 + wc * 32 + 8 * fq;
#pragma unroll
            for (int ai = 0; ai < 2; ++ai)
#pragma unroll
                for (int m = 0; m < 4; ++m) {
                    float r[8];
#pragma unroll
                    for (int n = 0; n < 2; ++n)
#pragma unroll
                        for (int e = 0; e < 4; ++e) { const float av = acc[ai][0][m][n][e], bv = acc[ai][1][m][n][e]; r[n * 4 + e] = av * sigmoidf_(av) * bv; }
                    u32x4 w; w.x = cvt_pk_bf16(r[0], r[1]); w.y = cvt_pk_bf16(r[2], r[3]); w.z = cvt_pk_bf16(r[4], r[5]); w.w = cvt_pk_bf16(r[6], r[7]);
                    *(u32x4*)(O + (size_t)(row0 + ai * 128 + m * 16) * DFF + col0) = w; }
        } else {
            const int br = u.sub >> 1; const bool isg = !(u.sub & 1);
            const int col0 = u.pn * 256 + wc * 32 + 8 * fq;
            u32x4* pk = park + tid; asm volatile("" : "+v"(pk));
#pragma unroll
            for (int bj = 0; bj < 2; ++bj) {
                f32x4 b0 = (f32x4){0.f, 0.f, 0.f, 0.f}, b1 = b0;
                if (isg) { const float* bp = bgate + br * 1024 + col0 + bj * 128; b0 = *(const f32x4*)bp * -1.4426950408889634f; b1 = *(const f32x4*)(bp + 4) * -1.4426950408889634f; }
#pragma unroll
                for (int ai = 0; ai < 2; ++ai)
#pragma unroll
                    for (int m = 0; m < 4; ++m) {
                        const f32x4 v0 = acc[ai][bj][m][0], v1 = acc[ai][bj][m][1];
                        u32x4* slot = pk + ((ai * 4 + m) * 2 + bj) * 512;
                        if (isg) {
#define SG2(v, bb) __builtin_amdgcn_rcpf(1.0f + __builtin_amdgcn_exp2f(__builtin_fmaf((v), -1.4426950408889634f, (bb))))
                            u32x4 w; w.x = cvt_pk_bf16(SG2(v0[0], b0[0]), SG2(v0[1], b0[1])); w.y = cvt_pk_bf16(SG2(v0[2], b0[2]), SG2(v0[3], b0[3]));
                            w.z = cvt_pk_bf16(SG2(v1[0], b1[0]), SG2(v1[1], b1[1])); w.w = cvt_pk_bf16(SG2(v1[2], b1[2]), SG2(v1[3], b1[3]));
#undef SG2
                            *slot = w;
                        } else {
                            const u32x4 g = *slot;
                            bf16_t* op = O + (size_t)(row0 + ai * 128 + m * 16) * ldc + col0 + bj * 128;
                            float r[8];
                            r[0] = bflo(g.x) * v0[0]; r[1] = bfhi(g.x) * v0[1]; r[2] = bflo(g.y) * v0[2]; r[3] = bfhi(g.y) * v0[3];
                            r[4] = bflo(g.z) * v1[0]; r[5] = bfhi(g.z) * v1[1]; r[6] = bflo(g.w) * v1[2]; r[7] = bfhi(g.w) * v1[3];
                            if (br > 0) { const u32x4 o = *(const u32x4*)op;
                                r[0] += bflo(o.x); r[1] += bfhi(o.x); r[2] += bflo(o.y); r[3] += bfhi(o.y); r[4] += bflo(o.z); r[5] += bfhi(o.z); r[6] += bflo(o.w); r[7] += bfhi(o.w); }
                            u32x4 w; w.x = cvt_pk_bf16(r[0], r[1]); w.y = cvt_pk_bf16(r[2], r[3]); w.z = cvt_pk_bf16(r[4], r[5]); w.w = cvt_pk_bf16(r[6], r[7]);
                            *(u32x4*)op = w;
                        }
                        if (m & 1) asm volatile("" ::: "memory");
                    }
            }
        }
    }
};

struct Args { const float* in[31]; float* out; unsigned char* ws; int ph_lo, ph_hi; };
struct Ctx {
    LAS unsigned long long* tab; int tid;
    __device__ __forceinline__ unsigned long long rd(int k) const { const unsigned long long v = tab[k];
        const unsigned lo = __builtin_amdgcn_readfirstlane((unsigned)v), hi = __builtin_amdgcn_readfirstlane((unsigned)(v >> 32)); return ((unsigned long long)hi << 32) | lo; }
    __device__ __forceinline__ const float* in(int k) const { return (const float*)(const __attribute__((address_space(1))) float*)rd(k); }
    __device__ __forceinline__ float* out() const { return (float*)(__attribute__((address_space(1))) float*)rd(31); }
    __device__ __forceinline__ unsigned char* ws() const { return (unsigned char*)(__attribute__((address_space(1))) unsigned char*)rd(32); }
};

__device__ __forceinline__ void tr_item(const float* W, int K, int N, bf16_t* WT, int item, LAS float* scr, int lane, bool upmap) {
    const int nblk = N / 32, kb = item / nblk, nb = item % nblk, k0 = 64 * kb, n0 = 32 * nb;
#pragma unroll 8
    for (int i = 0; i < 32; ++i) { const int kk = 2 * i + (lane >> 5); scr[kk * 33 + (lane & 31)] = W[(size_t)(k0 + kk) * N + n0 + (lane & 31)]; }
    asm volatile("s_waitcnt lgkmcnt(0)" ::: "memory");
    int row0 = n0;
    if (upmap) { if (n0 < DFF) row0 = 256 * (n0 / 128) + (n0 % 128); else { const int c2 = n0 - DFF; row0 = 256 * (c2 / 128) + 128 + (c2 % 128); } }
    const int c = lane & 7;
#pragma unroll
    for (int j = 0; j < 4; ++j) { const int n = (lane >> 3) + 8 * j; const LAS float* s = scr + (8 * c) * 33 + n;
        u32x4 o; o.x = cvt_pk_bf16(s[0 * 33], s[1 * 33]); o.y = cvt_pk_bf16(s[2 * 33], s[3 * 33]); o.z = cvt_pk_bf16(s[4 * 33], s[5 * 33]); o.w = cvt_pk_bf16(s[6 * 33], s[7 * 33]);
        *(u32x4*)(WT + (size_t)(row0 + n) * K + k0 + 8 * c) = o; }
    asm volatile("s_waitcnt lgkmcnt(0)" ::: "memory");
}

__device__ __forceinline__ void p0_prologue(const Ctx& a, LAS unsigned char* lds) {
    const int tid = a.tid, lane = tid & 63, wave = tid >> 6;
    const int gw = blockIdx.x * 8 + wave, NGW = gridDim.x * 8;
    LAS float* scr = (LAS float*)(lds + wave * 16384);
    bf16_t* Wb = (bf16_t*)(a.ws() + WS_W);
    constexpr int I_UP = 16 * 176, I_DN = 44 * 32, I_IN = 16 * 96, I_BR = 8 * 32, I_SQ = 16 * 32, I_LRU = 64;
    constexpr int ITEMS_L = 2 * I_UP + 2 * I_DN + 2 * I_IN + 3 * I_BR + 2 * I_SQ + I_LRU;
    for (int it = gw; it < NL * ITEMS_L; it += NGW) {
        const int l = it / ITEMS_L; int r = it - l * ITEMS_L;
        bf16_t* WLb = Wb + (size_t)l * WL;
        if (r < I_UP) { tr_item(a.in(5) + (size_t)l * 1024 * 5632, 1024, 5632, WLb + OFF_UP1, r, scr, lane, true); continue; } r -= I_UP;
        if (r < I_DN) { tr_item(a.in(6) + (size_t)l * DFF * 1024, DFF, 1024, WLb + OFF_DN1, r, scr, lane, false); continue; } r -= I_DN;
        if (r < I_UP) { tr_item(a.in(28) + (size_t)l * 1024 * 5632, 1024, 5632, WLb + OFF_UP2, r, scr, lane, true); continue; } r -= I_UP;
        if (r < I_DN) { tr_item(a.in(29) + (size_t)l * DFF * 1024, DFF, 1024, WLb + OFF_DN2, r, scr, lane, false); continue; } r -= I_DN;
        if (r < I_IN) { tr_item(a.in(9) + (size_t)l * 1024 * 3072, 1024, 3072, WLb + OFF_IN, r, scr, lane, false); continue; } r -= I_IN;
        if (r < I_IN) { tr_item(a.in(20) + (size_t)l * 1024 * 3072, 1024, 3072, WLb + OFF_GATE, r, scr, lane, false); continue; } r -= I_IN;
        if (r < I_BR) { tr_item(a.in(22) + (size_t)l * 512 * 1024, 512, 1024, WLb + OFF_BR, r, scr, lane, false); continue; } r -= I_BR;
        if (r < I_BR) { tr_item(a.in(23) + (size_t)l * 512 * 1024, 512, 1024, WLb + OFF_BR + 1024 * 512, r, scr, lane, false); continue; } r -= I_BR;
        if (r < I_BR) { tr_item(a.in(24) + (size_t)l * 512 * 1024, 512, 1024, WLb + OFF_BR + 2 * 1024 * 512, r, scr, lane, false); continue; } r -= I_BR;
        if (r < I_SQ) { tr_item(a.in(25) + (size_t)l * 1024 * 1024, 1024, 1024, WLb + OFF_OUT, r, scr, lane, false); continue; } r -= I_SQ;
        if (r < I_SQ) { tr_item(a.in(19) + (size_t)l * 1024 * 1024, 1024, 1024, WLb + OFF_KV, r, scr, lane, false); continue; } r -= I_SQ;
        { const int half = r & 1, n = (r >> 1) & 7, mat = (r >> 4) & 1, dir = r >> 5;
          const float* src = (mat ? a.in(15) : a.in(13)) + ((size_t)(l * 2 + dir) * 8 + n) * 4096;
          tr_item(src, 64, 64, WLb + OFF_LRU + ((size_t)(dir * 2 + mat) * 8 + n) * 4096, half, scr, lane, false); }
    }
    bf16_t* memN = (bf16_t*)(a.ws() + WS_B);
    for (int row = gw; row < 2560; row += NGW) {
        const float* src = row < 2048 ? a.in(2) + (size_t)row * 1024 : a.in(3) + (size_t)(row - 2048) * 1024;
        f32x4 v[4]; float ss = 0.f;
#pragma unroll
        for (int j = 0; j < 4; ++j) { v[j] = *(const f32x4*)(src + 4 * lane + 256 * j); ss += v[j][0] * v[j][0] + v[j][1] * v[j][1] + v[j][2] * v[j][2] + v[j][3] * v[j][3]; }
        const float rs = rsqrtf(wave_sum(ss) * (1.f / 1024.f) + EPS);
        for (int l = 0; l < NL; ++l) {
#pragma unroll
            for (int j = 0; j < 4; ++j) { const f32x4 g = *(const f32x4*)(a.in(18) + l * 1024 + 4 * lane + 256 * j);
                u32x2 w; w.x = cvt_pk_bf16(v[j][0] * rs * g[0], v[j][1] * rs * g[1]); w.y = cvt_pk_bf16(v[j][2] * rs * g[2], v[j][3] * rs * g[3]);
                *(u32x2*)(memN + ((size_t)l * 2560 + row) * 1024 + 4 * lane + 256 * j) = w; }
        }
    }
    bf16_t* HA = (bf16_t*)(a.ws() + WS_A);
    { const float* xin0 = a.in(0); const float* xin1 = a.in(1); const float* g1 = a.in(4); float* outp = a.out();
      f32x4 gg[4], vn[4];
#pragma unroll
      for (int j = 0; j < 4; ++j) { gg[j] = *(const f32x4*)(g1 + 4 * lane + 256 * j); vn[j] = (f32x4){0.f, 0.f, 0.f, 0.f}; }
      if (gw < T) { const float* src = gw < 65536 ? xin0 + (size_t)gw * 1024 : xin1 + (size_t)(gw - 65536) * 1024;
#pragma unroll
          for (int j = 0; j < 4; ++j) vn[j] = __builtin_nontemporal_load((const f32x4*)(src + 4 * lane + 256 * j)); }
      for (int row = gw; row < T; row += NGW) {
        f32x4 v[4]; float ss = 0.f;
#pragma unroll
        for (int j = 0; j < 4; ++j) { v[j] = vn[j]; ss += v[j][0] * v[j][0] + v[j][1] * v[j][1] + v[j][2] * v[j][2] + v[j][3] * v[j][3]; }
        const int nrow = row + NGW;
        if (nrow < T) { const float* src = nrow < 65536 ? xin0 + (size_t)nrow * 1024 : xin1 + (size_t)(nrow - 65536) * 1024;
#pragma unroll
            for (int j = 0; j < 4; ++j) vn[j] = __builtin_nontemporal_load((const f32x4*)(src + 4 * lane + 256 * j)); }
        const float rs = rsqrtf(wave_sum(ss) * (1.f / 1024.f) + EPS);
#pragma unroll
        for (int j = 0; j < 4; ++j) { const f32x4 g = gg[j];
            __builtin_nontemporal_store(v[j], (f32x4*)(outp + (size_t)row * 1024 + 4 * lane + 256 * j));
            u32x2 w; w.x = cvt_pk_bf16(v[j][0] * rs * g[0], v[j][1] * rs * g[1]); w.y = cvt_pk_bf16(v[j][2] * rs * g[2], v[j][3] * rs * g[3]);
            *(u32x2*)(HA + (size_t)row * 1024 + 4 * lane + 256 * j) = w; }
      } }
}

__device__ __forceinline__ void e_phase(const Ctx& a, float* X, bf16_t* FA, const float* gpost, float scale, const float* gpre) {
    const int tid = a.tid, lane = tid & 63, wave = tid >> 6;
    const int gw = blockIdx.x * 8 + wave, NGW = gridDim.x * 8;
    u32x2 fn[4]; f32x4 xn[4];
    f32x4 gp[4], gq[4];
#pragma unroll
    for (int j = 0; j < 4; ++j) { gp[j] = *(const f32x4*)(gpost + 4 * lane + 256 * j); gq[j] = gpre ? *(const f32x4*)(gpre + 4 * lane + 256 * j) : (f32x4){0.f, 0.f, 0.f, 0.f}; }
    if (gw < T) {
#pragma unroll
        for (int j = 0; j < 4; ++j) { fn[j] = *(const u32x2*)(FA + (size_t)gw * 1024 + 4 * lane + 256 * j); xn[j] = __builtin_nontemporal_load((const f32x4*)(X + (size_t)gw * 1024 + 4 * lane + 256 * j)); }
    }
    for (int row = gw; row < T; row += NGW) {
        float* xr = X + (size_t)row * 1024; bf16_t* fr = FA + (size_t)row * 1024;
        f32x4 f[4], x[4]; float ss = 0.f;
#pragma unroll
        for (int j = 0; j < 4; ++j) { f[j] = (f32x4){bflo(fn[j].x), bfhi(fn[j].x), bflo(fn[j].y), bfhi(fn[j].y)}; x[j] = xn[j];
            ss += f[j][0] * f[j][0] + f[j][1] * f[j][1] + f[j][2] * f[j][2] + f[j][3] * f[j][3]; }
        const int nrow = row + NGW;
        if (nrow < T) {
#pragma unroll
            for (int j = 0; j < 4; ++j) { fn[j] = *(const u32x2*)(FA + (size_t)nrow * 1024 + 4 * lane + 256 * j); xn[j] = __builtin_nontemporal_load((const f32x4*)(X + (size_t)nrow * 1024 + 4 * lane + 256 * j)); }
        }
        const float rs = rsqrtf(wave_sum(ss) * (1.f / 1024.f) + EPS) * scale;
        float s2 = 0.f;
#pragma unroll
        for (int j = 0; j < 4; ++j) { const f32x4 g = gp[j];
            x[j] = x[j] + f[j] * g * rs; __builtin_nontemporal_store(x[j], (f32x4*)(xr + 4 * lane + 256 * j));
            s2 += x[j][0] * x[j][0] + x[j][1] * x[j][1] + x[j][2] * x[j][2] + x[j][3] * x[j][3]; }
        if (gpre) {
            const float r2 = rsqrtf(wave_sum(s2) * (1.f / 1024.f) + EPS);
#pragma unroll
            for (int j = 0; j < 4; ++j) { const f32x4 g = gq[j];
                u32x2 w; w.x = cvt_pk_bf16(x[j][0] * r2 * g[0], x[j][1] * r2 * g[1]); w.y = cvt_pk_bf16(x[j][2] * r2 * g[2], x[j][3] * r2 * g[3]);
                *(u32x2*)(fr + 4 * lane + 256 * j) = w; }
        }
    }
}

template <bool NA>
__device__ __forceinline__ void attn_wave(bf16_t* PB, const bf16_t* KV, const float* rpb_h, int b, int hh, int r, int j, int qt, const bf16_t* VT, int lane, LAS float* RP) {
    constexpr int D = NA ? 64 : 128, NDC = D / 32, NDT = D / 16;
    const int c15 = lane & 15, g = lane >> 4;
    int rs = 0, bs = 0; size_t qtok; bf16_t* qp;
    if (NA) { qtok = (size_t)b * SEQ + r * 64 + 16 * j + c15; qp = PB + qtok * PC + hh * 64; rs = min(max(r - 4, 0), 120); bs = min(max(16 * j - 8, 0), 32); }
    else { qtok = (size_t)b * SEQ + qt * 16 + c15; qp = PB + qtok * PC + 2560 + hh * 128; }
    bf16x8 qf[NDC];
#pragma unroll
    for (int dc = 0; dc < NDC; ++dc) qf[dc] = *(const bf16x8*)(qp + 32 * dc + 8 * g);
    if (NA) {
#pragma unroll
        for (int i = 0; i < 8; ++i) { const int idx = lane + 64 * i; if (idx < 465) RP[idx] = rpb_h[idx]; }
        __builtin_amdgcn_wave_barrier();
    }
    f32x4 S[16];
#pragma unroll
    for (int kt = 0; kt < 16; ++kt) {
        const bf16_t* kp;
        if (NA) { const size_t ktok = (size_t)b * SEQ + (rs + (kt >> 1)) * 64 + bs + 16 * (kt & 1) + c15; kp = PB + ktok * PC + 512 + hh * 64; }
        else kp = KV + (size_t)(b * 256 + 16 * kt + c15) * 1024 + hh * 128;
        f32x4 acc = (f32x4){0.f, 0.f, 0.f, 0.f};
#pragma unroll
        for (int dc = 0; dc < NDC; ++dc) { const bf16x8 kf = *(const bf16x8*)(kp + 32 * dc + 8 * g); acc = __builtin_amdgcn_mfma_f32_16x16x32_bf16(kf, qf[dc], acc, 0, 0, 0); }
        S[kt] = acc;
    }
    const float scale = NA ? 0.125f : 0.08838834764831845f;
    float mx = -3.0e38f;
#pragma unroll
    for (int kt = 0; kt < 16; ++kt)
#pragma unroll
        for (int jj = 0; jj < 4; ++jj) {
            float s = S[kt][jj] * scale;
            if (NA) {
                const int kc = bs + 16 * (kt & 1) + 4 * g + jj, qc = 16 * j + c15, wsq = min(max(qc - 8, 0), 48);
                const bool valid = (kc >= wsq) && (kc < wsq + 16);
                const int dci = min(max(kc - qc, -15), 15) + 15, dri = rs + (kt >> 1) - r + 7;
                s = valid ? s + RP[dri * 31 + dci] : -1.0e30f;
            }
            S[kt][jj] = s; mx = fmaxf(mx, s);
        }
    mx = fmaxf(mx, __shfl_xor(mx, 16)); mx = fmaxf(mx, __shfl_xor(mx, 32));
    float sum = 0.f;
#pragma unroll
    for (int kt = 0; kt < 16; ++kt)
#pragma unroll
        for (int jj = 0; jj < 4; ++jj) { const float p = __expf(S[kt][jj] - mx); S[kt][jj] = p; sum += p; }
    sum += __shfl_xor(sum, 16); sum += __shfl_xor(sum, 32);
    const float inv = 1.0f / sum;
    f32x4 O[NDT];
#pragma unroll
    for (int dt = 0; dt < NDT; ++dt) O[dt] = (f32x4){0.f, 0.f, 0.f, 0.f};
#pragma unroll
    for (int kc8 = 0; kc8 < 8; ++kc8) {
        u32x4 pw; pw.x = cvt_pk_bf16(S[2 * kc8][0], S[2 * kc8][1]); pw.y = cvt_pk_bf16(S[2 * kc8][2], S[2 * kc8][3]);
        pw.z = cvt_pk_bf16(S[2 * kc8 + 1][0], S[2 * kc8 + 1][1]); pw.w = cvt_pk_bf16(S[2 * kc8 + 1][2], S[2 * kc8 + 1][3]);
        const bf16x8 pb = __builtin_bit_cast(bf16x8, pw);
#pragma unroll
        for (int dt = 0; dt < NDT; ++dt) {
            bf16x8 vf;
            if (NA) { const bf16_t* vp = VT + ((((size_t)(b * 8 + hh) * 128 + (rs + kc8)) * 64 + 16 * dt + c15) * 64) + bs + 4 * g;
                      const u32x2 p0 = *(const u32x2*)vp, p1 = *(const u32x2*)(vp + 16); u32x4 t; t.x = p0.x; t.y = p0.y; t.z = p1.x; t.w = p1.y; vf = __builtin_bit_cast(bf16x8, t); }
            else vf = *(const bf16x8*)(VT + (((size_t)(b * 4 + hh) * 128 + 16 * dt + c15) * 256) + 32 * kc8 + 8 * g);
            O[dt] = __builtin_amdgcn_mfma_f32_16x16x32_bf16(vf, pb, O[dt], 0, 0, 0);
        }
    }
#pragma unroll
    for (int dt = 0; dt < NDT; ++dt) { u32x2 w; w.x = cvt_pk_bf16(O[dt][0] * inv, O[dt][1] * inv); w.y = cvt_pk_bf16(O[dt][2] * inv, O[dt][3] * inv);
        *(u32x2*)(qp + 16 * dt + 4 * g) = w; }
}

constexpr int L_XC = 0, L_WA = 34816, L_HB = 38912, L_WL = 104448, L_CW = 122880, L_RP = 124416;
__device__ __forceinline__ void na_block(bf16_t* PB, const bf16_t* VT, const float* rpb_h, int b, int hh, int rp, LAS unsigned char* lds, int tid, bool fill_rp, u32x4 (&kpre)[9], bf16x8 (&qpre)[2], bool have, int nx) {
    const bool has_next = nx < 5120; const int nb = nx >> 9, nhh = nx & 7, nrp = (nx >> 3) & 63;
    const int lane = tid & 63, w = tid >> 6, c15 = lane & 15, g = lane >> 4;
    const int r = 2 * rp + (w >> 2), j = w & 3;
    const int rsU = min(max(2 * rp - 4, 0), 120), rs = min(max(r - 4, 0), 120), ro = rs - rsU, bs = min(max(16 * j - 8, 0), 32);
    LAS unsigned char* KS = lds;
    LAS float* RP = (LAS float*)(lds + L_RP + w * 2048);
    __syncthreads();
    if (!have) {
        { unsigned off = ((unsigned)(b * SEQ + rsU * 64 + (tid >> 3)) * (unsigned)PC + (unsigned)(512 + hh * 64 + 8 * (tid & 7))) * 2u;
#pragma unroll
          for (int i = 0; i < 9; ++i) { kpre[i] = (rsU + i) < 128 ? *(const u32x4*)((const char*)PB + off) : (u32x4){0u, 0u, 0u, 0u}; off += 64u * PC * 2u; } }
    }
#pragma unroll
    for (int i = 0; i < 9; ++i) { const int v = tid + 512 * i; *(LAS u32x4*)(KS + (v >> 3) * 144 + (v & 7) * 16) = kpre[i]; }
    if (fill_rp) {
#pragma unroll
        for (int i = 0; i < 8; ++i) { const int idx = lane + 64 * i; if (idx < 465) RP[idx] = 1.4426950408889634f * rpb_h[idx]; }
    }
    bf16_t* qp = PB + ((size_t)b * SEQ + r * 64 + 16 * j + c15) * PC + hh * 64;
    bf16x8 qf[2];
    if (!have) {
#pragma unroll
        for (int dc = 0; dc < 2; ++dc) qpre[dc] = *(const bf16x8*)(qp + 32 * dc + 8 * g);
    }
#pragma unroll
    for (int dc = 0; dc < 2; ++dc) qf[dc] = qpre[dc];
    __syncthreads();
    f32x4 S[16];
#pragma unroll
    for (int kt = 0; kt < 16; ++kt) {
        const int key = (ro + (kt >> 1)) * 64 + bs + 16 * (kt & 1) + c15;
        f32x4 acc = (f32x4){0.f, 0.f, 0.f, 0.f};
#pragma unroll
        for (int dc = 0; dc < 2; ++dc) { const bf16x8 kf = *(const LAS bf16x8*)(KS + key * 144 + (32 * dc + 8 * g) * 2); acc = __builtin_amdgcn_mfma_f32_16x16x32_bf16(kf, qf[dc], acc, 0, 0, 0); }
        S[kt] = acc;
        if ((kt & 3) == 3) asm volatile("" ::: "memory");
    }
    u32x4 vv[9];
    { unsigned off = ((unsigned)((((b * 8 + hh) * 128 + rsU) * 64 + (tid >> 3)) * 64) + (unsigned)(8 * (tid & 7))) * 2u;
#pragma unroll
      for (int i = 0; i < 9; ++i) { vv[i] = (rsU + i) < 128 ? *(const u32x4*)((const char*)VT + off) : (u32x4){0u, 0u, 0u, 0u}; off += 64u * 64u * 2u; } }
    float mx = -3.0e38f;
#pragma unroll
    for (int kt = 0; kt < 16; ++kt)
#pragma unroll
        for (int jj = 0; jj < 4; ++jj) {
            const int kc = bs + 16 * (kt & 1) + 4 * g + jj, qc = 16 * j + c15, wsq = min(max(qc - 8, 0), 48);
            const bool valid = (kc >= wsq) && (kc < wsq + 16);
            const int dci = min(max(kc - qc, -15), 15) + 15, dri = rs + (kt >> 1) - r + 7;
            const float sv = valid ? __builtin_fmaf(S[kt][jj], 0.125f * 1.4426950408889634f, RP[dri * 31 + dci]) : -1.0e30f;
            S[kt][jj] = sv; mx = fmaxf(mx, sv);
        }
    mx = fmaxf(mx, __shfl_xor(mx, 16)); mx = fmaxf(mx, __shfl_xor(mx, 32));
    float sum = 0.f;
#pragma unroll
    for (int kt = 0; kt < 16; ++kt)
#pragma unroll
        for (int jj = 0; jj < 4; ++jj) { const float p = __builtin_amdgcn_exp2f(S[kt][jj] - mx); S[kt][jj] = p; sum += p; }
    sum += __shfl_xor(sum, 16); sum += __shfl_xor(sum, 32);
    const float inv = 1.0f / sum;
    __syncthreads();
#pragma unroll
    for (int i = 0; i < 9; ++i) { const int v = tid + 512 * i; *(LAS u32x4*)(KS + (v >> 3) * 144 + (v & 7) * 16) = vv[i]; }
    if (has_next) {
        const int nrsU = min(max(2 * nrp - 4, 0), 120);
        { unsigned off = ((unsigned)(nb * SEQ + nrsU * 64 + (tid >> 3)) * (unsigned)PC + (unsigned)(512 + nhh * 64 + 8 * (tid & 7))) * 2u;
#pragma unroll
          for (int i = 0; i < 9; ++i) { kpre[i] = (nrsU + i) < 128 ? *(const u32x4*)((const char*)PB + off) : (u32x4){0u, 0u, 0u, 0u}; off += 64u * PC * 2u; } }
        const bf16_t* nqp = PB + ((size_t)nb * SEQ + (2 * nrp + (w >> 2)) * 64 + 16 * j + c15) * PC + nhh * 64;
#pragma unroll
        for (int dc = 0; dc < 2; ++dc) qpre[dc] = *(const bf16x8*)(nqp + 32 * dc + 8 * g);
    }
    __syncthreads();
    f32x4 O[4];
#pragma unroll
    for (int dt = 0; dt < 4; ++dt) O[dt] = (f32x4){0.f, 0.f, 0.f, 0.f};
#pragma unroll
    for (int kc8 = 0; kc8 < 8; ++kc8) {
        u32x4 pw; pw.x = cvt_pk_bf16(S[2 * kc8][0], S[2 * kc8][1]); pw.y = cvt_pk_bf16(S[2 * kc8][2], S[2 * kc8][3]);
        pw.z = cvt_pk_bf16(S[2 * kc8 + 1][0], S[2 * kc8 + 1][1]); pw.w = cvt_pk_bf16(S[2 * kc8 + 1][2], S[2 * kc8 + 1][3]);
        const bf16x8 pb = __builtin_bit_cast(bf16x8, pw);
#pragma unroll
        for (int dt = 0; dt < 4; ++dt) {
            const LAS unsigned char* vp = KS + ((ro + kc8) * 64 + 16 * dt + c15) * 144 + (bs + 4 * g) * 2;
            const u32x2 p0 = *(const LAS u32x2*)vp, p1 = *(const LAS u32x2*)(vp + 32);
            u32x4 t; t.x = p0.x; t.y = p0.y; t.z = p1.x; t.w = p1.y;
            O[dt] = __builtin_amdgcn_mfma_f32_16x16x32_bf16(__builtin_bit_cast(bf16x8, t), pb, O[dt], 0, 0, 0);
        }
        if (kc8 & 1) asm volatile("" ::: "memory");
    }
#pragma unroll
    for (int dt = 0; dt < 4; ++dt) { u32x2 wv; wv.x = cvt_pk_bf16(O[dt][0] * inv, O[dt][1] * inv); wv.y = cvt_pk_bf16(O[dt][2] * inv, O[dt][3] * inv);
        *(u32x2*)(qp + 16 * dt + 4 * g) = wv; }
}

__device__ __forceinline__ void ca_block(bf16_t* PB, const bf16_t* KV, const bf16_t* VT, int b, int hh, int q256, LAS unsigned char* lds, int tid, u32x4 (&pk)[8], u32x4 (&pv)[8], bool have, int nx) {
    const int lane = tid & 63, w = tid >> 6, c15 = lane & 15, g = lane >> 4;
    LAS unsigned char* Ks = lds;
    LAS unsigned char* Vs = lds + 69632;
    if (!have) {
#pragma unroll
        for (int i = 0; i < 8; ++i) { const int v = tid + 512 * i, row = v >> 4, c16 = v & 15; pk[i] = *(const u32x4*)(KV + (size_t)(b * 256 + row) * 1024 + hh * 128 + 8 * c16); }
#pragma unroll
        for (int i = 0; i < 8; ++i) { const int v = tid + 512 * i, drow = v >> 5, c32 = v & 31; pv[i] = *(const u32x4*)(VT + ((size_t)(b * 4 + hh) * 128 + drow) * 256 + 8 * c32); }
    }
    __syncthreads();
#pragma unroll
    for (int i = 0; i < 8; ++i) { const int v = tid + 512 * i; *(LAS u32x4*)(Ks + (v >> 4) * 272 + (v & 15) * 16) = pk[i]; }
#pragma unroll
    for (int i = 0; i < 8; ++i) { const int v = tid + 512 * i; *(LAS u32x4*)(Vs + (v >> 5) * 528 + (v & 31) * 16) = pv[i]; }
    __syncthreads();
    if (nx < 1280) {
        const int nhh = nx & 3, nb = nx >> 7;
#pragma unroll
        for (int i = 0; i < 8; ++i) { const int v = tid + 512 * i, row = v >> 4, c16 = v & 15; pk[i] = *(const u32x4*)(KV + (size_t)(nb * 256 + row) * 1024 + nhh * 128 + 8 * c16); }
#pragma unroll
        for (int i = 0; i < 8; ++i) { const int v = tid + 512 * i, drow = v >> 5, c32 = v & 31; pv[i] = *(const u32x4*)(VT + ((size_t)(nb * 4 + nhh) * 128 + drow) * 256 + 8 * c32); }
    }
#pragma unroll 1
    for (int round = 0; round < 2; ++round) {
        const int qt = q256 * 16 + round * 8 + w;
        bf16_t* qp = PB + ((size_t)b * SEQ + qt * 16 + c15) * PC + 2560 + hh * 128;
        bf16x8 qf[4];
#pragma unroll
        for (int dc = 0; dc < 4; ++dc) qf[dc] = *(const bf16x8*)(qp + 32 * dc + 8 * g);
        f32x4 S[16];
#pragma unroll
        for (int kt = 0; kt < 16; ++kt) {
            f32x4 acc = (f32x4){0.f, 0.f, 0.f, 0.f};
#pragma unroll
            for (int dc = 0; dc < 4; ++dc) { const bf16x8 kf = *(const LAS bf16x8*)(Ks + (16 * kt + c15) * 272 + (32 * dc + 8 * g) * 2); acc = __builtin_amdgcn_mfma_f32_16x16x32_bf16(kf, qf[dc], acc, 0, 0, 0); }
            S[kt] = acc;
            if (kt & 1) asm volatile("" ::: "memory");
        }
        float mx = -3.0e38f;
#pragma unroll
        for (int kt = 0; kt < 16; ++kt)
#pragma unroll
            for (int jj = 0; jj < 4; ++jj) { const float sv = S[kt][jj] * (0.08838834764831845f * 1.4426950408889634f); S[kt][jj] = sv; mx = fmaxf(mx, sv); }
        mx = fmaxf(mx, __shfl_xor(mx, 16)); mx = fmaxf(mx, __shfl_xor(mx, 32));
        float sum = 0.f;
#pragma unroll
        for (int kt = 0; kt < 16; ++kt)
#pragma unroll
            for (int jj = 0; jj < 4; ++jj) { const float p = __builtin_amdgcn_exp2f(S[kt][jj] - mx); S[kt][jj] = p; sum += p; }
        sum += __shfl_xor(sum, 16); sum += __shfl_xor(sum, 32);
        const float inv = 1.0f / sum;
        f32x4 O[8];
#pragma unroll
        for (int dt = 0; dt < 8; ++dt) O[dt] = (f32x4){0.f, 0.f, 0.f, 0.f};
#pragma unroll
        for (int kc8 = 0; kc8 < 8; ++kc8) {
            u32x4 pw; pw.x = cvt_pk_bf16(S[2 * kc8][0], S[2 * kc8][1]); pw.y = cvt_pk_bf16(S[2 * kc8][2], S[2 * kc8][3]);
            pw.z = cvt_pk_bf16(S[2 * kc8 + 1][0], S[2 * kc8 + 1][1]); pw.w = cvt_pk_bf16(S[2 * kc8 + 1][2], S[2 * kc8 + 1][3]);
            const bf16x8 pb = __builtin_bit_cast(bf16x8, pw);
#pragma unroll
            for (int dt = 0; dt < 8; ++dt) { const bf16x8 vf = *(const LAS bf16x8*)(Vs + (16 * dt + c15) * 528 + (32 * kc8 + 8 * g) * 2); O[dt] = __builtin_amdgcn_mfma_f32_16x16x32_bf16(vf, pb, O[dt], 0, 0, 0); }
            asm volatile("" ::: "memory");
        }
#pragma unroll
        for (int dt = 0; dt < 8; ++dt) { u32x2 wv; wv.x = cvt_pk_bf16(O[dt][0] * inv, O[dt][1] * inv); wv.y = cvt_pk_bf16(O[dt][2] * inv, O[dt][3] * inv);
            *(u32x2*)(qp + 16 * dt + 4 * g) = wv; }
    }
}

constexpr int LSEG = 512, NSEG = SEQ / LSEG;
__device__ __forceinline__ void lru_item(const Ctx& a, LAS unsigned char* lds, int l, int b, int n, int seg, int pass, const int tid) {
    const int lane = tid & 63, w = tid >> 6, c15 = lane & 15, g = lane >> 4;
    unsigned char* ws = a.ws();
    bf16_t* PB = (bf16_t*)(ws + WS_B); float* AGG = (float*)(ws + WS_AGG);
    const bf16_t* LW = (const bf16_t*)(ws + WS_W) + (size_t)l * WL + OFF_LRU;
    const int cb = 64 * n; const size_t tok0 = (size_t)b * SEQ;
    LAS float* XC = (LAS float*)(lds + L_XC);
    LAS float* WA = (LAS float*)(lds + L_WA);
    LAS bf16_t* HB = (LAS bf16_t*)(lds + L_HB);
    LAS unsigned char* WLs = lds + L_WL;
    LAS float* CWs = (LAS float*)(lds + L_CW);
    LAS float* AGs = (LAS float*)(lds + L_RP);
    const float* cw = a.in(11) + (size_t)l * 4 * 512 + cb; const float* cbias = a.in(12) + (size_t)l * 512 + cb;
    const int cg8 = tid & 7;
    u32x4 wpre[2]; f32x4 agpre = (f32x4){0.f, 0.f, 0.f, 0.f};
    LAS float* CPs = (LAS float*)(lds + 133120);
    u32x4 xr[2][4];
    auto load_consts = [&](int d) {
        const bf16_t* Wsrc = LW + ((size_t)(d * 2) * 8 + n) * 4096;
#pragma unroll
        for (int i = 0; i < 2; ++i) { const int v = tid + 512 * i, mat = v >> 9, row = (v >> 3) & 63, c8 = v & 7; wpre[i] = *(const u32x4*)(Wsrc + (size_t)mat * 8 * 4096 + row * 64 + 8 * c8); }
        if (pass == 1) agpre = *(const f32x4*)(AGG + ((size_t)((b * 8 + n) * 2 + d) * NSEG) * 128 + 4 * tid);
    };
    auto load_x = [&](int dir, int c) {
        const int tl0n = dir ? LSEG - 128 * (c + 1) : 128 * c; const int t0n = seg * LSEG + tl0n;
        const bool interior = (t0n >= 2) && (t0n + 130 <= SEQ);
#pragma unroll
        for (int rep = 0; rep < 2; ++rep) { const int tokl = (tid + 512 * rep) >> 3;
            const int ts0 = t0n + tokl - 2;
            unsigned off = ((unsigned)((int)tok0 + ts0) * (unsigned)PC + (unsigned)(1536 + cb + 8 * cg8)) * 2u;
            if (interior) {
#pragma unroll
                for (int tap = 0; tap < 4; ++tap) { xr[rep][tap] = *(const u32x4*)((const char*)PB + off); off += PC * 2; }
            } else {
#pragma unroll
                for (int tap = 0; tap < 4; ++tap) { const int ts = ts0 + tap;
                    xr[rep][tap] = (ts >= 0 && ts < SEQ) ? *(const u32x4*)((const char*)PB + off) : (u32x4){0u, 0u, 0u, 0u}; off += PC * 2; }
            } }
    };
    load_consts(1); load_x(1, 0);
    if (tid < 320) CWs[tid] = tid < 256 ? cw[(tid >> 6) * 512 + (tid & 63)] : cbias[tid - 256];
    if (tid >= 384) { const int d = (tid - 384) >> 6, chl = tid & 63, ch = (l * 2 + d) * 512 + cb + chl;
        const float lam = a.in(17)[ch];
        CPs[d * 192 + chl] = -1.4426950408889634f * a.in(14)[ch]; CPs[d * 192 + 64 + chl] = -1.4426950408889634f * a.in(16)[ch];
        CPs[d * 192 + 128 + chl] = -8.0f * 1.4426950408889634f * ((lam > 15.f) ? __expf(-lam) : log1pf(__expf(-lam))); }
#pragma unroll
    for (int sweep = 0; sweep < 2; ++sweep) {
        const int dir = 1 - sweep;
#pragma unroll
        for (int i = 0; i < 2; ++i) { const int v = tid + 512 * i, mat = v >> 9, row = (v >> 3) & 63, c8 = v & 7; *(LAS u32x4*)(WLs + mat * 9216 + row * 144 + c8 * 16) = wpre[i]; }
        if (pass == 1) *(LAS f32x4*)(AGs + 4 * tid) = agpre;
        float ba[4], bi[4], sp[4], hin[4], ain[4];
#pragma unroll
        for (int nt = 0; nt < 4; ++nt) { hin[nt] = 0.f; ain[nt] = 1.f; }
        __syncthreads();
#pragma unroll
        for (int nt = 0; nt < 4; ++nt) { ba[nt] = CPs[dir * 192 + 16 * nt + c15]; bi[nt] = CPs[dir * 192 + 64 + 16 * nt + c15]; sp[nt] = CPs[dir * 192 + 128 + 16 * nt + c15]; }
        if (pass == 1) {
#pragma unroll
            for (int nt = 0; nt < 4; ++nt) { float h0 = 0.f;
                if (dir == 0) { for (int s2 = 0; s2 < seg; ++s2) { const LAS float* q = AGs + s2 * 128 + (16 * nt + c15) * 2; h0 = q[0] * h0 + q[1]; } }
                else { for (int s2 = NSEG - 1; s2 > seg; --s2) { const LAS float* q = AGs + s2 * 128 + (16 * nt + c15) * 2; h0 = q[0] * h0 + q[1]; } }
                hin[nt] = h0; }
        }
        for (int c = 0; c < LSEG / 128; ++c) {
            const int tl0 = dir ? LSEG - 128 * (c + 1) : 128 * c;
#pragma unroll
            for (int rep = 0; rep < 2; ++rep) {
                const int tokl = (tid + 512 * rep) >> 3, i = dir ? 127 - tokl : tokl;
                f32x4 o0 = *(const LAS f32x4*)(CWs + 256 + 8 * cg8), o1 = *(const LAS f32x4*)(CWs + 256 + 8 * cg8 + 4);
#pragma unroll
                for (int tap = 0; tap < 4; ++tap) {
                    const u32x4 xv = xr[rep][tap];
                    const f32x4 w0 = *(const LAS f32x4*)(CWs + tap * 64 + 8 * cg8), w1 = *(const LAS f32x4*)(CWs + tap * 64 + 8 * cg8 + 4);
                    o0[0] += bflo(xv.x) * w0[0]; o0[1] += bfhi(xv.x) * w0[1]; o0[2] += bflo(xv.y) * w0[2]; o0[3] += bfhi(xv.y) * w0[3];
                    o1[0] += bflo(xv.z) * w1[0]; o1[1] += bfhi(xv.z) * w1[1]; o1[2] += bflo(xv.w) * w1[2]; o1[3] += bfhi(xv.w) * w1[3];
                }
                *(LAS f32x4*)(XC + i * 68 + 8 * cg8) = o0;
                *(LAS f32x4*)(XC + i * 68 + 8 * cg8 + 4) = o1;
            }
            if (c + 1 < LSEG / 128) load_x(dir, c + 1);
            bf16_t gq[4][4];
            const unsigned gbase = ((unsigned)((int)tok0 + seg * LSEG + tl0 + 16 * w + 4 * g) * (unsigned)PC + (unsigned)(2048 + cb + c15)) * 2u;
            if (pass == 1 && sweep == 1) {
#pragma unroll
                for (int nt = 0; nt < 4; ++nt)
#pragma unroll
                    for (int jj = 0; jj < 4; ++jj) gq[nt][jj] = *(const bf16_t*)((const char*)PB + gbase + (unsigned)(jj * PC * 2 + nt * 32));
            }
            __syncthreads();
            bf16x8 Af[2];
#pragma unroll
            for (int kc = 0; kc < 2; ++kc) { const f32x4 x0 = *(const LAS f32x4*)(XC + (16 * w + c15) * 68 + 32 * kc + 8 * g), x1 = *(const LAS f32x4*)(XC + (16 * w + c15) * 68 + 32 * kc + 8 * g + 4);
                u32x4 pw; pw.x = cvt_pk_bf16(x0[0], x0[1]); pw.y = cvt_pk_bf16(x0[2], x0[3]); pw.z = cvt_pk_bf16(x1[0], x1[1]); pw.w = cvt_pk_bf16(x1[2], x1[3]); Af[kc] = __builtin_bit_cast(bf16x8, pw); }
            float hl[4][4], pc[4][4], eA[4], eH[4];
#pragma unroll
            for (int nt = 0; nt < 4; ++nt) {
                f32x4 pr = (f32x4){0.f, 0.f, 0.f, 0.f}, pi = pr;
#pragma unroll
                for (int kc = 0; kc < 2; ++kc) {
                    const bf16x8 wa8 = *(const LAS bf16x8*)(WLs + (16 * nt + c15) * 144 + (32 * kc + 8 * g) * 2), wi8 = *(const LAS bf16x8*)(WLs + 9216 + (16 * nt + c15) * 144 + (32 * kc + 8 * g) * 2);
                    pr = __builtin_amdgcn_mfma_f32_16x16x32_bf16(Af[kc], wa8, pr, 0, 0, 0); pi = __builtin_amdgcn_mfma_f32_16x16x32_bf16(Af[kc], wi8, pi, 0, 0, 0); }
                float hp = 0.f, pp = 1.f;
#pragma unroll
                for (int jj = 0; jj < 4; ++jj) {
                    const float rg = __builtin_amdgcn_rcpf(1.0f + __builtin_amdgcn_exp2f(__builtin_fmaf(pr[jj], -1.4426950408889634f, ba[nt])));
                    const float ig = __builtin_amdgcn_rcpf(1.0f + __builtin_amdgcn_exp2f(__builtin_fmaf(pi[jj], -1.4426950408889634f, bi[nt])));
                    const float av = __builtin_amdgcn_exp2f(rg * sp[nt]); const float mu = __builtin_amdgcn_sqrtf(fmaxf(__builtin_fmaf(-av, av, 1.0f), 0.f));
                    const float xv = XC[(16 * w + 4 * g + jj) * 68 + 16 * nt + c15];
                    const float uv = mu * ig * xv;
                    hp = av * hp + uv; pp = av * pp; hl[nt][jj] = hp; pc[nt][jj] = pp;
                }
                float iA = pp, iH = hp;
                float tA = __shfl_up(iA, 16), tH = __shfl_up(iH, 16); if (g >= 1) { iH = iA * tH + iH; iA = iA * tA; }
                tA = __shfl_up(iA, 32); tH = __shfl_up(iH, 32); if (g >= 2) { iH = iA * tH + iH; iA = iA * tA; }
                float xA = __shfl_up(iA, 16), xH = __shfl_up(iH, 16); if (g == 0) { xA = 1.f; xH = 0.f; }
                eA[nt] = xA; eH[nt] = xH;
                if (g == 3) { WA[(w * 64 + 16 * nt + c15) * 2] = iA; WA[(w * 64 + 16 * nt + c15) * 2 + 1] = iH; }
            }
            if (c + 1 == LSEG / 128 && sweep == 0) { load_consts(0); load_x(0, 0); }
            __syncthreads();
#pragma unroll
            for (int nt = 0; nt < 4; ++nt) {
                float cwv = hin[nt], cin = 0.f, ap = ain[nt];
#pragma unroll
                for (int w2 = 0; w2 < 8; ++w2) { const float A2 = WA[(w2 * 64 + 16 * nt + c15) * 2], H2 = WA[(w2 * 64 + 16 * nt + c15) * 2 + 1]; if (w2 == w) cin = cwv; cwv = A2 * cwv + H2; ap *= A2; }
                hin[nt] = cwv; ain[nt] = ap;
                if (pass == 1) {
                    const float cl = eA[nt] * cin + eH[nt];
#pragma unroll
                    for (int jj = 0; jj < 4; ++jj) {
                        const float hv = pc[nt][jj] * cl + hl[nt][jj];
                        const int i = 16 * w + 4 * g + jj, tl = tl0 + (dir ? 127 - i : i); const int ch = 16 * nt + c15;
                        if (sweep == 0) { HB[tl * 64 + ch] = (bf16_t)(cvt_pk_bf16(hv, 0.f) & 0xffffu); }
                        else { const float hb = bf2f(HB[tl * 64 + ch]); const float gl = bf2f(gq[nt][jj]);
                               *(bf16_t*)((char*)PB + gbase + (unsigned)(jj * PC * 2 + nt * 32)) = (bf16_t)(cvt_pk_bf16((hv + hb) * gelu_tanh(gl), 0.f) & 0xffffu); }
                    }
                }
            }
        }
        if (pass == 0 && w == 0 && g == 0) {
            float* q = AGG + ((size_t)((b * 8 + n) * 2 + dir) * NSEG + seg) * 128;
#pragma unroll
            for (int nt = 0; nt < 4; ++nt) { __hip_atomic_store(q + (16 * nt + c15) * 2, ain[nt], __ATOMIC_RELAXED, __HIP_MEMORY_SCOPE_AGENT); __hip_atomic_store(q + (16 * nt + c15) * 2 + 1, hin[nt], __ATOMIC_RELAXED, __HIP_MEMORY_SCOPE_AGENT); }
        }
        __syncthreads();
    }
}

__device__ __forceinline__ void mixer_phase(const Ctx& a, LAS unsigned char* lds, int l, int pass) {
    const int tid = a.tid;
    bf16_t* PB = (bf16_t*)(a.ws() + WS_B);
    const bf16_t* KV = (const bf16_t*)(a.ws() + WS_KVB) + (size_t)l * 2560 * 1024;
    constexpr int N_LRU = 80 * NSEG, N_NA = 5120, N_CA = 1280;
    const int G = (int)gridDim.x;
    for (int it = blockIdx.x; it < N_LRU; it += G) {
        int t2 = tid; asm volatile("" : "+v"(t2));
#ifndef SKIP_LRU
        lru_item(a, lds, l, it / (8 * NSEG), (it / NSEG) & 7, it % NSEG, pass, t2);
        __syncthreads();
#endif
    }
    if (pass == 0) {
        { int x0 = ((int)blockIdx.x - N_LRU) % G; if (x0 < 0) x0 += G;
          u32x4 kpre[9]; bf16x8 qpre[2];
          for (int x = x0; x < N_NA; x += G) {
              int t2 = tid; asm volatile("" : "+v"(t2));
              const int hh = x & 7, rp = (x >> 3) & 63, b = x >> 9;
#ifndef SKIP_NA
              na_block(PB, (const bf16_t*)(a.ws() + WS_S), a.in(10) + (size_t)(l * 8 + hh) * 465, b, hh, rp, lds, t2, (x == x0) || (gridDim.x & 7u), kpre, qpre, x != x0, x + G);
#endif
          } }
        { int x0 = ((int)blockIdx.x - N_LRU - N_NA) % G; if (x0 < 0) x0 += G;
          u32x4 pk[8], pv[8];
          for (int x = x0; x < N_CA; x += G) {
              int t2 = tid; asm volatile("" : "+v"(t2));
              const int hh = x & 3, q256 = (x >> 2) & 31, b = x >> 7;
#ifndef SKIP_CA
              ca_block(PB, KV, (const bf16_t*)(a.ws() + WS_VTC) + (size_t)l * 10 * 4 * 128 * 256, b, hh, q256, lds, t2, pk, pv, x != x0, x + G);
#endif
          } }
    }
    __syncthreads();
}

#define XB_TMO      128
#define XB_XCNT(j)  (256  + 64 * (j))
#define XB_XSUB(j)  (1280 + 64 * (j))
#define XB_XGEN(j)  (2304 + 64 * (j))
#define XB_TOP      3328
#define XB_TOPGEN   3392
#define XCD_BAR_WORDS 3456
#define XB_SPIN_CAP (1u << 22)
__device__ __forceinline__ unsigned xb_ld(unsigned* p)              { return __hip_atomic_load(p, __ATOMIC_RELAXED, __HIP_MEMORY_SCOPE_AGENT); }
__device__ __forceinline__ unsigned xb_add(unsigned* p, unsigned v) { return __hip_atomic_fetch_add(p, v, __ATOMIC_RELAXED, __HIP_MEMORY_SCOPE_AGENT); }
__device__ __forceinline__ unsigned xb_xcc_id() { return (unsigned)__builtin_amdgcn_s_getreg((3 << 11) | 20) & 0xFu; }
#define XB_SPIN(cond, bar) do { unsigned _sp = 0; while (cond) { __builtin_amdgcn_s_sleep(1); \
    if ((++_sp & 255u) == 0u) { if (xb_ld(&(bar)[XB_TMO])) break; if (_sp > XB_SPIN_CAP) { atomicAdd(&(bar)[XB_TMO], 1u); break; } } } } while (0)
struct XcdBarrier { unsigned* bar; unsigned x; volatile LAS unsigned* st; };
__device__ __forceinline__ XcdBarrier xcd_barrier_post(unsigned* bar, volatile LAS unsigned* st) {
    XcdBarrier b; b.bar = bar; b.x = xb_xcc_id(); b.st = st;
    if (threadIdx.x == 0) (void)xb_add(&bar[XB_XCNT(b.x)], 1u);
    return b;
}
__device__ __forceinline__ void xcd_barrier_complete(unsigned* bar, unsigned x, unsigned& nloc, unsigned& nx) {
    const unsigned G = gridDim.x * gridDim.y * gridDim.z;
    unsigned sum, cnt, mine, sp = 0u;
    for (;;) {
        sum = 0u; cnt = 0u; mine = 0u;
#pragma unroll
        for (unsigned j = 0; j < 16; ++j) { const unsigned c = xb_ld(&bar[XB_XCNT(j)]); sum += c; cnt += (c > 0u) ? 1u : 0u; mine = (j == x) ? c : mine; }
        if (sum == G) break;
        __builtin_amdgcn_s_sleep(1);
        if ((++sp & 255u) == 0u) { if (xb_ld(&bar[XB_TMO])) break; if (sp > XB_SPIN_CAP) { atomicAdd(&bar[XB_TMO], 1u); break; } }
    }
    nloc = mine > 0u ? mine : 1u; nx = cnt > 0u ? cnt : 1u;
}
__device__ __forceinline__ void xcd_barrier(const XcdBarrier& b) {
    asm volatile("s_waitcnt vmcnt(0)" ::: "memory");
    __syncthreads();
    if (threadIdx.x == 0) {
        unsigned* bar = b.bar;
        __builtin_amdgcn_s_waitcnt(0);
        unsigned nloc = b.st[0], nx = b.st[1];
        if (nloc == 0u) { xcd_barrier_complete(bar, b.x, nloc, nx); b.st[0] = nloc; b.st[1] = nx; }
        const unsigned old = xb_add(&bar[XB_XSUB(b.x)], 1u);
        const unsigned gen = old / nloc;
        if (old + 1u == (gen + 1u) * nloc) {
            __builtin_amdgcn_fence(__ATOMIC_RELEASE, "agent");
            asm volatile("s_waitcnt vmcnt(0)" ::: "memory");
            const unsigned og = xb_add(&bar[XB_TOP], 1u);
            const unsigned tg = og / nx;
            if (og + 1u == (tg + 1u) * nx) xb_add(&bar[XB_TOPGEN], 1u);
            else XB_SPIN(xb_ld(&bar[XB_TOPGEN]) == tg, bar);
            __builtin_amdgcn_fence(__ATOMIC_ACQUIRE, "agent");
            xb_add(&bar[XB_XGEN(b.x)], 1u);
            asm volatile("s_waitcnt vmcnt(0)" ::: "memory");
        } else {
            XB_SPIN(xb_ld(&bar[XB_XGEN(b.x)]) == gen, bar);
            __builtin_amdgcn_fence(__ATOMIC_ACQUIRE, "agent");
            asm volatile("s_waitcnt vmcnt(0)" ::: "memory");
        }
    }
    __syncthreads();
}

constexpr int NPL = 12, NPH = 2 + NPL * NL;
__global__ void __launch_bounds__(512, 2) mega(Args args) {
    extern __shared__ __attribute__((aligned(16))) unsigned char lds_raw[];
    LAS unsigned char* lds = (LAS unsigned char*)lds_raw;
    cg::grid_group grid = cg::this_grid();
    Ctx a; a.tab = (LAS unsigned long long*)(lds + 141000);
    { const unsigned long long* ka = (const unsigned long long*)__builtin_amdgcn_kernarg_segment_ptr();
      if (threadIdx.x < 33) a.tab[threadIdx.x] = ka[threadIdx.x];
      if (threadIdx.x == 64) { ((LAS unsigned*)(lds + 141500))[0] = 0u; ((LAS unsigned*)(lds + 141500))[1] = 0u; } }
    __syncthreads();
    XcdBarrier xbar = xcd_barrier_post((unsigned*)(args.ws + WS_CTL), (volatile LAS unsigned*)(lds + 141500));
    const int ph_lo = args.ph_lo, ph_hi = args.ph_hi;
    for (int ph = ph_lo; ph < ph_hi; ++ph) {
        if (ph > ph_lo) { if (ph == ph_lo + 1) grid.sync(); else xcd_barrier(xbar); }
        int tid = threadIdx.x; asm volatile("" : "+v"(tid));
        a.tid = tid;
        const int G = gridDim.x, c = blockIdx.x;
        unsigned char* ws = a.ws();
        const char* Wb = (const char*)(ws + WS_W);
        bf16_t* bufA = (bf16_t*)(ws + WS_A); bf16_t* bufB = (bf16_t*)(ws + WS_B);
        if (ph == 0) {
#ifndef SKIP_P0
            p0_prologue(a, lds);
#endif
            continue; }
        const int l = ph >= 2 ? (ph - 2) / NPL : 0, s = ph >= 2 ? (ph - 2) % NPL : -1;
        const char* WLc = Wb + (size_t)l * WL * 2;
        if (s == 2 || s == 8 || s == 11) {
            const float* gpost = a.in(s == 2 ? 7 : (s == 8 ? 26 : 30)) + l * 1024;
            const float* gpre = s == 2 ? a.in(8) + l * 1024 : (s == 8 ? a.in(27) + l * 1024 : (l + 1 < NL ? a.in(4) + (l + 1) * 1024 : nullptr));
#ifndef SKIP_E
            e_phase(a, a.out(), bufA, gpost, s == 8 ? 1.0f : 0.5f, gpre);
#endif
            continue;
        }
        if (s == 4 || s == 5) {
#ifndef SKIP_MIX
            mixer_phase(a, lds, l, s - 4);
#endif
            continue;
        }
        USched S; UEpi E;
        S.kind = 0; S.Wg = nullptr; S.Wbr = nullptr; S.PB = nullptr; E.kind = 0; E.bgate = nullptr; E.park = nullptr; E.O = bufA; E.ldc = 1024; E.vt = 0; E.VT = nullptr;
        S.A = (const char*)bufA; S.lda = 2048; S.B = WLc; S.ldb = 2048; S.nt = 16;
        if (ph == 1) { S.kind = 1; S.o.G = G; S.o.c = c; S.o.nM = 0; S.o.nN = 0; S.o.nwg = 0; S.A = (const char*)(ws + WS_B); S.B = Wb; E.O = (bf16_t*)(ws + WS_KVB); E.ldc = 1024; E.vt = 2; E.VT = (bf16_t*)(ws + WS_VTC); }
        else if (s == 0 || s == 9) { S.o.init(T, 5632, G, c); S.B = WLc + (s == 0 ? OFF_UP1 : OFF_UP2) * 2; E.kind = 1; E.O = bufB; E.ldc = DFF; }
        else if (s == 1 || s == 10) { S.o.init(T, 1024, G, c); S.A = (const char*)bufB; S.lda = DFF * 2; S.B = WLc + (s == 1 ? OFF_DN1 : OFF_DN2) * 2; S.ldb = DFF * 2; S.nt = 44; }
        else if (s == 3) { S.o.init(T, 3072, G, c); S.B = WLc + OFF_IN * 2; E.O = bufB; E.ldc = PC; E.vt = 1; E.VT = (bf16_t*)(ws + WS_S); }
        else if (s == 7) { S.o.init(T, 1024, G, c); S.A = (const char*)(bufB + 512); S.lda = PC * 2; S.B = WLc + OFF_OUT * 2; }
        else {
            S.kind = 2; S.o.init(T, 1024, G, c); S.PB = (const char*)bufB; S.Wg = WLc + OFF_GATE * 2; S.Wbr = WLc + OFF_BR * 2;
            E.kind = 2; E.O = bufB + 512; E.ldc = PC; E.bgate = a.in(21) + (size_t)l * 3072; E.park = (u32x4*)(ws + WS_S) + (size_t)c * 16 * 512;
        }
#ifndef SKIP_GEMM
        pg8::gemm_phase<UEpi, USched>(lds, tid, S, E);
#endif
    }
}

extern "C" void kernel_launch(void* const* d_in, const int* in_sizes, int n_in, void* d_out, int out_size, void* d_ws, size_t ws_size, hipStream_t stream) {
    static int grid = 0;
    if (grid == 0) {
        if (n_in != 31 || ws_size < WS_END || out_size != T * 1024) { fprintf(stderr, "kernel_launch: unexpected shapes (n_in %d, out %d, ws %zu)\n", n_in, out_size, ws_size); grid = -1; return; }
        int dev = 0, cus = 0, per_cu = 0;
        hipGetDevice(&dev); hipDeviceGetAttribute(&cus, hipDeviceAttributeMultiprocessorCount, dev);
        hipFuncSetAttribute((const void*)mega, hipFuncAttributeMaxDynamicSharedMemorySize, LDS_BYTES);
        hipOccupancyMaxActiveBlocksPerMultiprocessor(&per_cu, (const void*)mega, 512, LDS_BYTES);
        if (per_cu < 1) per_cu = 1;
        (void)hipGetLastError();
        grid = cus * per_cu;
    }
    if (grid < 0) return;
    hipMemsetAsync((char*)d_ws + WS_CTL, 0, 16384, stream);
    Args a{};
    for (int i = 0; i < 31; ++i) a.in[i] = (const float*)d_in[i];
    a.out = (float*)d_out; a.ws = (unsigned char*)d_ws;
#if MULTI_LAUNCH
    for (int ph = 0; ph < NPH; ++ph) { a.ph_lo = ph; a.ph_hi = ph + 1; hipLaunchKernelGGL(mega, dim3(grid), dim3(512), LDS_BYTES, stream, a); }
#else
    a.ph_lo = 0; a.ph_hi = NPH;
    void* args[] = {&a};
    hipError_t e = hipLaunchCooperativeKernel((const void*)mega, dim3(grid), dim3(512), args, LDS_BYTES, stream);
    if (e != hipSuccess) fprintf(stderr, "cooperative launch failed: %s (grid %d)\n", hipGetErrorString(e), grid);
#endif
}
```
